# Optimizing an MI355X kernel written in HIP

```python
import jax, jax.numpy as jnp
from jax import lax
import numpy as np

D_MODEL = 1024
BATCH = 4
SEQ = 8192
DEPTH = 1

N_ATTN_HEADS = 8
HEAD_DIM = 64
ATTN_WIDTH = N_ATTN_HEADS * HEAD_DIM
CONV_GROUPS = 8
CONV_WIDTH = 512
CONV_K = 3
D_FF = 4 * D_MODEL
PLE_DIM = 256
Q_BLOCK = 128
EPS = 1e-6
SPLIT_SIZES = (ATTN_WIDTH, ATTN_WIDTH, ATTN_WIDTH, CONV_WIDTH, CONV_WIDTH, CONV_WIDTH, D_MODEL, D_MODEL)
SPLIT_POINTS = tuple(int(v) for v in np.cumsum(SPLIT_SIZES)[:-1])
D_IN = sum(SPLIT_SIZES)

kernel_name = 'hybrid_stickbreak_shortconv_block'


def rms_norm(x, g):
    xf = x.astype(jnp.float32)
    var = jnp.mean(xf * xf, axis=-1, keepdims=True)
    return (xf * lax.rsqrt(var + EPS) * g.astype(jnp.float32)).astype(x.dtype)


def stick_breaking_attention(q, k, v):
    b, h, s, dh = q.shape
    nblk = s // Q_BLOCK
    scale = dh ** -0.5
    kf = k.astype(jnp.float32)
    vf = v.astype(jnp.float32)
    q_blocks = q.reshape(b, h, nblk, Q_BLOCK, dh).transpose(2, 0, 1, 3, 4)
    key_pos = jnp.arange(s, dtype=jnp.int32)
    starts = jnp.arange(nblk, dtype=jnp.int32) * Q_BLOCK

    def block(args):
        qb, start = args
        z = jnp.einsum('bhqd,bhkd->bhqk', qb.astype(jnp.float32), kf) * scale
        q_pos = start + jnp.arange(Q_BLOCK, dtype=jnp.int32)
        causal = key_pos[None, :] < q_pos[:, None]
        log_beta = jax.nn.log_sigmoid(z)
        log_keep = jnp.where(causal, log_beta - z, 0.0)
        between = lax.cumsum(log_keep, axis=3, reverse=True) - log_keep
        w = jnp.where(causal, jnp.exp(log_beta + between), 0.0)
        return jnp.einsum('bhqk,bhkd->bhqd', w, vf)

    out = lax.map(block, (q_blocks, starts))
    return out.transpose(1, 2, 0, 3, 4).reshape(b, h, s, dh).astype(q.dtype)


def causal_depthwise_conv(u, w):
    c = u.shape[-1]
    return lax.conv_general_dilated(
        u, w[:, None, :].astype(u.dtype), window_strides=(1,),
        padding=((CONV_K - 1, 0),), dimension_numbers=('NWC', 'WIO', 'NWC'),
        feature_group_count=c)


def setup_inputs(seed: int = 0) -> dict:
    key = jax.random.key(seed)
    ks = jax.random.split(key, 20)
    f32 = jnp.float32

    def nrm(k, shape, fan_in):
        return jax.random.normal(k, shape, f32) * (fan_in ** -0.5)

    def gain(k, shape):
        return jnp.ones(shape, f32) + 0.05 * jax.random.normal(k, shape, f32)

    return {
        'x': jax.random.normal(ks[0], (BATCH, SEQ, D_MODEL), f32),
        'p': jax.random.normal(ks[1], (DEPTH, BATCH, SEQ, PLE_DIM), f32),
        'g_pre_mix': gain(ks[2], (DEPTH, D_MODEL)),
        'w_in': nrm(ks[3], (DEPTH, D_MODEL, D_IN), D_MODEL),
        'b_gate': 0.1 * jax.random.normal(ks[4], (DEPTH, 2 * D_MODEL), f32),
        'w_conv': nrm(ks[5], (DEPTH, CONV_K, CONV_WIDTH), CONV_K),
        'w_attn_out': nrm(ks[6], (DEPTH, ATTN_WIDTH, D_MODEL), ATTN_WIDTH),
        'w_conv_out': nrm(ks[7], (DEPTH, CONV_WIDTH, D_MODEL), CONV_WIDTH),
        'w_o': nrm(ks[8], (DEPTH, D_MODEL, D_MODEL), D_MODEL),
        'g_post_mix': gain(ks[9], (DEPTH, D_MODEL)),
        'g_pre_mlp': gain(ks[10], (DEPTH, D_MODEL)),
        'w_up': nrm(ks[11], (DEPTH, D_MODEL, D_FF), D_MODEL),
        'w_down': nrm(ks[12], (DEPTH, D_FF, D_MODEL), D_FF),
        'g_post_mlp': gain(ks[13], (DEPTH, D_MODEL)),
        'g_ple': gain(ks[14], (DEPTH, D_MODEL)),
        'w_ple_gate': nrm(ks[15], (DEPTH, D_MODEL, D_MODEL), D_MODEL),
        'w_ple_proj': nrm(ks[16], (DEPTH, PLE_DIM, D_MODEL), PLE_DIM),
    }


def reference(x, p, g_pre_mix, w_in, b_gate, w_conv, w_attn_out, w_conv_out, w_o,
              g_post_mix, g_pre_mlp, w_up, w_down, g_post_mlp, g_ple, w_ple_gate, w_ple_proj):
    bsz, seq, _ = x.shape
    for i in range(DEPTH):
        h = rms_norm(x, g_pre_mix[i])
        proj = h @ w_in[i]
        q, k, v, cb, cc, cu, ga, gc = jnp.split(proj, SPLIT_POINTS, axis=-1)

        def heads(t):
            return t.reshape(bsz, seq, N_ATTN_HEADS, HEAD_DIM).transpose(0, 2, 1, 3)

        o = stick_breaking_attention(heads(q), heads(k), heads(v))
        o = o.transpose(0, 2, 1, 3).reshape(bsz, seq, ATTN_WIDTH)
        y_attn = o @ w_attn_out[i]

        y_conv = (cb * causal_depthwise_conv(cc * cu, w_conv[i])) @ w_conv_out[i]

        gates = jax.nn.sigmoid(jnp.concatenate([ga, gc], axis=-1) + b_gate[i])
        gate_attn, gate_conv = jnp.split(gates, 2, axis=-1)
        mixed = (gate_attn * y_attn + gate_conv * y_conv) @ w_o[i]
        x = x + rms_norm(mixed, g_post_mix[i])

        h = rms_norm(x, g_pre_mlp[i])
        f = jnp.square(jax.nn.relu(h @ w_up[i])) @ w_down[i]
        x = x + rms_norm(f, g_post_mlp[i])

        ple_gate = jax.nn.sigmoid(rms_norm(x, g_ple[i]) @ w_ple_gate[i])
        x = x + ple_gate * (p[i] @ w_ple_proj[i])
    return x
```

```cpp
#include <hip/hip_runtime.h>
#include <hip/hip_cooperative_groups.h>
#include <cstdio>
#include <cstdint>
namespace cg = cooperative_groups;
namespace pg8 {
#define PG8_LAS __attribute__((address_space(3)))
typedef unsigned short bf16_t;
typedef short bf16x8 __attribute__((ext_vector_type(8)));
typedef float f32x4 __attribute__((ext_vector_type(4)));
typedef unsigned u32x4 __attribute__((ext_vector_type(4)));
constexpr int BM = 256, BK = 64, HALF = 128, HTB = HALF * BK * 2  , STAGE_BYTES = 8 * HTB, NXCD = 8, WGM = 8;

__host__ __device__ __forceinline__ int lds_byte(int r, int c) { const int st = (r >> 4) * 2 + (c >> 5), rr = r & 15, cc = c & 31, ob = rr * 64 + cc * 2; return st * 1024 + (ob ^ (((ob >> 9) & 1) << 5)); }
__host__ __device__ __forceinline__ void stage_rc(int b, int& R, int& C) { const int st = b / 1024, sb = b % 1024, swz = sb ^ (((sb >> 9) & 1) << 5); R = (st >> 1) * 16 + swz / 64; C = (st & 1) * 32 + (swz % 64) / 2; }
__host__ __device__ __forceinline__ int perm32(int rho) { const int n = rho >> 4, i = rho & 15; return 8 * (i >> 2) + 4 * n + (i & 3); }

struct Unit { int pm, pn; };
struct Gemm { const bf16_t* A; const bf16_t* Bt; int M, N, K; };

struct StaticOrder {
    int nM, nN, nwg, G, c;
    __host__ __device__ void init(int M, int N, int G_, int c_) { nM = M / BM; nN = N / BM; nwg = nM * nN; G = G_; c = c_; }
    __host__ __device__ bool next(int i, Unit& u) const {
        const long L = (long)i * G + c; if (L >= nwg) return false;
        int wgid = (int)L; { const int q = nwg / NXCD, r = nwg % NXCD, xcd = wgid % NXCD, off = wgid / NXCD; wgid = (xcd < r ? xcd * (q + 1) : r * (q + 1) + (xcd - r) * q) + off; }
        const int nig = WGM * nN, gid = wgid / nig, fm = gid * WGM, gsz = (nM - fm) < WGM ? (nM - fm) : WGM;
        u.pm = fm + ((wgid % nig) % gsz); u.pn = (wgid % nig) / gsz; return true;
    }
    __device__ __forceinline__ void a_ready(const Unit&) const {}
    __device__ __forceinline__ void done(const Unit&) const {}
};

__device__ __forceinline__ unsigned cvt_pk_bf16(float lo, float hi) { unsigned r; asm volatile("v_cvt_pk_bf16_f32 %0, %1, %2" : "=v"(r) : "v"(lo), "v"(hi)); return r; }
typedef float f32x2 __attribute__((ext_vector_type(2)));
typedef __bf16 bf16x2_t __attribute__((ext_vector_type(2)));
__device__ __forceinline__ unsigned pk_bf16(float lo, float hi) { f32x2 v = {lo, hi}; bf16x2_t b = __builtin_convertvector(v, bf16x2_t); return __builtin_bit_cast(unsigned, b); }
__device__ __forceinline__ float bf_lo(unsigned w) { return __uint_as_float(w << 16); }
__device__ __forceinline__ float bf_hi(unsigned w) { return __uint_as_float(w & 0xffff0000u); }
__device__ __forceinline__ float sigmoidf_fast(float x) { return __builtin_amdgcn_rcpf(1.0f + __builtin_amdgcn_exp2f(-1.4426950408889634f * x)); }
__device__ __forceinline__ u32x4 pack8(const f32x4 a, const f32x4 b) { u32x4 w; w.x = pk_bf16(a[0], a[1]); w.y = pk_bf16(a[2], a[3]); w.z = pk_bf16(b[0], b[1]); w.w = pk_bf16(b[2], b[3]); return w; }
__device__ __forceinline__ void unpack8(const u32x4 w, f32x4& a, f32x4& b) { a = (f32x4){bf_lo(w.x), bf_hi(w.x), bf_lo(w.y), bf_hi(w.y)}; b = (f32x4){bf_lo(w.z), bf_hi(w.z), bf_lo(w.w), bf_hi(w.w)}; }

template <class F> struct EpiTile8 {
    static constexpr bool PERM = true, AFTER_DRAIN = false;
    F f;
    __device__ __forceinline__ void operator()(const f32x4 (&acc)[2][2][4][2], const Unit& u, int wr, int wc, int fr, int fq) const {
        const int row0 = u.pm * BM + wr * 64 + fr, col0 = u.pn * BM + wc * 32 + 8 * fq;
#pragma unroll
        for (int ai = 0; ai < 2; ++ai)
#pragma unroll
            for (int m = 0; m < 4; ++m)
#pragma unroll
                for (int bj = 0; bj < 2; ++bj) f(row0 + ai * HALF + m * 16, col0 + bj * HALF, u.pn, acc[ai][bj][m][0], acc[ai][bj][m][1]);
    }
};
struct FProj { bf16_t* O; const float* bgate;
    __device__ __forceinline__ void operator()(int row, int col, int pn, f32x4 v0, f32x4 v1) const {
        if (pn >= 12) { const f32x4 b0 = *(const f32x4*)(bgate + col - 3072), b1 = *(const f32x4*)(bgate + col - 3072 + 4);
#pragma unroll
            for (int i = 0; i < 4; ++i) { v0[i] = sigmoidf_fast(v0[i] + b0[i]); v1[i] = sigmoidf_fast(v1[i] + b1[i]); } }
        *(u32x4*)(O + (size_t)row * 5120 + col) = pack8(v0, v1); } };
struct FMixA { bf16_t* MB; const bf16_t* G;
    __device__ __forceinline__ void operator()(int row, int col, int, f32x4 v0, f32x4 v1) const {
        f32x4 g0, g1; unpack8(*(const u32x4*)(G + (size_t)row * 5120 + col), g0, g1);
        *(u32x4*)(MB + (size_t)row * 1024 + col) = pack8(v0 * g0, v1 * g1); } };
struct FMixC { bf16_t* MB; const bf16_t* G;
    __device__ __forceinline__ void operator()(int row, int col, int, f32x4 v0, f32x4 v1) const {
        f32x4 g0, g1, m0, m1; unpack8(*(const u32x4*)(G + (size_t)row * 5120 + col), g0, g1); unpack8(*(const u32x4*)(MB + (size_t)row * 1024 + col), m0, m1);
        *(u32x4*)(MB + (size_t)row * 1024 + col) = pack8(m0 + v0 * g0, m1 + v1 * g1); } };
template <int ACT  > struct FStore { bf16_t* O; int ldc;
    __device__ __forceinline__ void operator()(int row, int col, int, f32x4 v0, f32x4 v1) const {
        if (ACT == 1) {
#pragma unroll
            for (int i = 0; i < 4; ++i) { const float a = fmaxf(v0[i], 0.f), b = fmaxf(v1[i], 0.f); v0[i] = a * a; v1[i] = b * b; } }
        if (ACT == 2) {
#pragma unroll
            for (int i = 0; i < 4; ++i) { v0[i] = sigmoidf_fast(v0[i]); v1[i] = sigmoidf_fast(v1[i]); } }
        *(u32x4*)(O + (size_t)row * ldc + col) = pack8(v0, v1); } };
struct FFinal { float* out; const bf16_t* GB;
    __device__ __forceinline__ void operator()(int row, int col, int, f32x4 v0, f32x4 v1) const {
        f32x4 g0, g1; unpack8(*(const u32x4*)(GB + (size_t)row * 1024 + col), g0, g1);
        float* p = out + (size_t)row * 1024 + col; const f32x4 x0 = *(const f32x4*)p, x1 = *(const f32x4*)(p + 4);
        *(f32x4*)p = x0 + g0 * v0; *(f32x4*)(p + 4) = x1 + g1 * v1; } };

template <class Epi, class Sched, bool ALIGN_EPI = false, bool SP2 = false>
__device__ __forceinline__ void gemm_phase(PG8_LAS unsigned char* lds, const Gemm g, const Sched& S, const Epi& E) {
    const int tid = threadIdx.x, wid = __builtin_amdgcn_readfirstlane(tid >> 6), lane = tid & 63, wr = wid >> 2, wc = wid & 3, fr = lane & 15, fq = lane >> 4;
    const int K = g.K, nt = K / BK;
    unsigned voffA[2], voffB[2];
#pragma unroll
    for (int i = 0; i < 2; ++i) { int R, C; stage_rc(tid * 16 + i * 8192, R, C); const int Rb = Epi::PERM ? ((R & ~31) + perm32(R & 31)) : R;
        voffA[i] = (unsigned)(R * K + C) * 2u; voffB[i] = (unsigned)(Rb * K + C) * 2u; }
    const size_t kstep = (size_t)(BK * 2);
    const size_t hstep = (size_t)HALF * K * 2;
    const size_t tstep = 2 * hstep;
    const unsigned ldsw = (unsigned)wid * 1024u;
    const int aoff = lds_byte(wr * 64 + fr, fq * 8), boff = lds_byte(wc * 32 + fr, fq * 8);
#define PG8_SA(b, h) (((b) * 2 + (h)) * HTB)
#define PG8_SB(b, h) ((4 + (b) * 2 + (h)) * HTB)
#define PG8_STAGE(bufoff, gbase, voff) do { _Pragma("unroll") for (int _i = 0; _i < 2; ++_i) \
        __builtin_amdgcn_global_load_lds((const unsigned*)((const char*)(gbase) + (voff)[_i]), (PG8_LAS unsigned*)(lds + (bufoff) + ldsw + _i * 8192), 16, 0, 0); } while (0)
#define PG8_LDA(dst, b, h) do { _Pragma("unroll") for (int m = 0; m < 4; ++m) _Pragma("unroll") for (int k = 0; k < 2; ++k) dst[m][k] = *(const PG8_LAS bf16x8*)(lds + PG8_SA(b, h) + aoff + m * 2048 + k * 1024); } while (0)
#define PG8_LDB(dst, b, h) do { _Pragma("unroll") for (int n = 0; n < 2; ++n) _Pragma("unroll") for (int k = 0; k < 2; ++k) dst[n][k] = *(const PG8_LAS bf16x8*)(lds + PG8_SB(b, h) + boff + n * 2048 + k * 1024); } while (0)
#define PG8_MMA(ai, bj, At, Bt) do { __builtin_amdgcn_s_setprio(1); _Pragma("unroll") for (int m = 0; m < 4; ++m) _Pragma("unroll") for (int n = 0; n < 2; ++n) _Pragma("unroll") for (int k = 0; k < 2; ++k) \
        acc[ai][bj][m][n] = __builtin_amdgcn_mfma_f32_16x16x32_bf16(Bt[n][k], At[m][k], acc[ai][bj][m][n], 0, 0, 0); __builtin_amdgcn_s_setprio(0); } while (0)
#define PG8_WAIT_V(n) asm volatile("s_waitcnt vmcnt(" #n ")" ::: "memory")
#define PG8_WAIT_L(n) asm volatile("s_waitcnt lgkmcnt(" #n ")" ::: "memory")
#define PG8_BAR __builtin_amdgcn_s_barrier()
#define PG8_SCHED __builtin_amdgcn_sched_barrier(0)
    Unit cur, nxt; int ui = 0;
    if (!S.next(0, cur)) return;
    f32x4 acc[2][2][4][2];
#pragma unroll
    for (int a = 0; a < 2; ++a)
#pragma unroll
        for (int b = 0; b < 2; ++b)
#pragma unroll
            for (int m = 0; m < 4; ++m)
#pragma unroll
                for (int n = 0; n < 2; ++n) acc[a][b][m][n] = (f32x4){0.f, 0.f, 0.f, 0.f};
    bf16x8 At[4][2], B0[2][2], B1[2][2];
    const char* cA = (const char*)g.A + (size_t)cur.pm * tstep; const char* cB = (const char*)g.Bt + (size_t)cur.pn * tstep;
    S.a_ready(cur);
    if constexpr (SP2) {
        PG8_STAGE(PG8_SB(0, 0), cB, voffB); PG8_STAGE(PG8_SB(0, 1), cB + hstep, voffB); PG8_STAGE(PG8_SA(0, 0), cA, voffA); PG8_STAGE(PG8_SA(0, 1), cA + hstep, voffA);
        if (wr == 1) PG8_BAR;
        PG8_WAIT_V(2); PG8_BAR;
        PG8_STAGE(PG8_SB(1, 0), cB + kstep, voffB); PG8_STAGE(PG8_SA(1, 0), cA + kstep, voffA); PG8_STAGE(PG8_SB(1, 1), cB + hstep + kstep, voffB);
        PG8_WAIT_V(6); PG8_BAR;
    } else {
        PG8_STAGE(PG8_SB(0, 0), cB, voffB); PG8_STAGE(PG8_SA(0, 0), cA, voffA); PG8_STAGE(PG8_SB(0, 1), cB + hstep, voffB); PG8_STAGE(PG8_SA(0, 1), cA + hstep, voffA);
        if (wr == 1) PG8_BAR;
        PG8_WAIT_V(4); PG8_BAR;
        PG8_STAGE(PG8_SB(1, 0), cB + kstep, voffB); PG8_STAGE(PG8_SA(1, 0), cA + kstep, voffA); PG8_STAGE(PG8_SB(1, 1), cB + hstep + kstep, voffB);
        PG8_WAIT_V(6); PG8_BAR;
    }
    for (;;) {
        const bool has_next = S.next(ui + 1, nxt);
        const char* nA = has_next ? (const char*)g.A + (size_t)nxt.pm * tstep : cA; const char* nB = has_next ? (const char*)g.Bt + (size_t)nxt.pn * tstep : cB;
        for (int t = 0; t < nt; t += 2) {
            const bool last = (t == nt - 2);
            const char* a1 = cA + (size_t)(t + 1) * kstep;
            const char* a2 = last ? nA : cA + (size_t)(t + 2) * kstep; const char* b2 = last ? nB : cB + (size_t)(t + 2) * kstep;
            const char* a3 = a2 + kstep; const char* b3 = b2 + kstep;
            if (last && has_next) S.a_ready(nxt);
            if constexpr (SP2) {
            PG8_LDB(B0, 0, 0); PG8_LDB(B1, 0, 1); PG8_SCHED; PG8_LDA(At, 0, 0); PG8_STAGE(PG8_SA(1, 1), a1 + hstep, voffA);
            PG8_WAIT_V(8); PG8_WAIT_L(0); PG8_BAR; PG8_MMA(0, 0, At, B0); PG8_MMA(0, 1, At, B1); PG8_BAR; PG8_SCHED;
            PG8_LDA(At, 0, 1); PG8_STAGE(PG8_SB(0, 0), b2, voffB); PG8_STAGE(PG8_SB(0, 1), b2 + hstep, voffB); PG8_STAGE(PG8_SA(0, 0), a2, voffA);
            PG8_WAIT_V(8); PG8_WAIT_L(0); PG8_BAR; PG8_MMA(1, 0, At, B0); PG8_MMA(1, 1, At, B1); PG8_BAR; PG8_SCHED;
            PG8_LDB(B0, 1, 0); PG8_LDB(B1, 1, 1); PG8_SCHED; PG8_LDA(At, 1, 0); PG8_STAGE(PG8_SA(0, 1), a2 + hstep, voffA);
            PG8_WAIT_V(8); PG8_WAIT_L(0); PG8_BAR; PG8_MMA(0, 0, At, B0); PG8_MMA(0, 1, At, B1); PG8_BAR; PG8_SCHED;
            PG8_LDA(At, 1, 1); PG8_STAGE(PG8_SB(1, 0), b3, voffB); PG8_STAGE(PG8_SB(1, 1), b3 + hstep, voffB); PG8_STAGE(PG8_SA(1, 0), a3, voffA);
            PG8_WAIT_V(8); PG8_WAIT_L(0); PG8_BAR; PG8_MMA(1, 0, At, B0); PG8_MMA(1, 1, At, B1); PG8_BAR; PG8_SCHED;
            } else {
            PG8_LDB(B0, 0, 0); PG8_SCHED; PG8_LDA(At, 0, 0); PG8_STAGE(PG8_SA(1, 1), a1 + hstep, voffA);
            PG8_WAIT_L(8); PG8_BAR; PG8_WAIT_L(0); PG8_MMA(0, 0, At, B0); PG8_BAR; PG8_SCHED;
            PG8_LDB(B1, 0, 1); PG8_STAGE(PG8_SB(0, 0), b2, voffB);
            PG8_BAR; PG8_WAIT_L(0); PG8_MMA(0, 1, At, B1); PG8_BAR;
            PG8_LDA(At, 0, 1); PG8_STAGE(PG8_SA(0, 0), a2, voffA);
            PG8_BAR; PG8_WAIT_L(0); PG8_MMA(1, 0, At, B0); PG8_BAR; PG8_SCHED;
            PG8_STAGE(PG8_SB(0, 1), b2 + hstep, voffB);
            PG8_WAIT_V(6); PG8_BAR; PG8_MMA(1, 1, At, B1); PG8_BAR;
            PG8_LDB(B0, 1, 0); PG8_SCHED; PG8_LDA(At, 1, 0); PG8_STAGE(PG8_SA(0, 1), a2 + hstep, voffA);
            PG8_WAIT_L(8); PG8_BAR; PG8_WAIT_L(0); PG8_MMA(0, 0, At, B0); PG8_BAR; PG8_SCHED;
            PG8_LDB(B1, 1, 1); PG8_STAGE(PG8_SB(1, 0), b3, voffB);
            PG8_BAR; PG8_WAIT_L(0); PG8_MMA(0, 1, At, B1); PG8_BAR;
            PG8_LDA(At, 1, 1); PG8_STAGE(PG8_SA(1, 0), a3, voffA);
            PG8_BAR; PG8_WAIT_L(0); PG8_MMA(1, 0, At, B0); PG8_BAR; PG8_SCHED;
            PG8_STAGE(PG8_SB(1, 1), b3 + hstep, voffB);
            PG8_WAIT_V(6); PG8_BAR; PG8_MMA(1, 1, At, B1); PG8_BAR;
            }
        }
        if constexpr (ALIGN_EPI) { if (wr == 0) PG8_BAR; }
        if constexpr (!Epi::AFTER_DRAIN) { E(acc, cur, wr, wc, fr, fq); S.done(cur); }
        if (!has_next) break;
#pragma unroll
        for (int a = 0; a < 2; ++a)
#pragma unroll
            for (int b = 0; b < 2; ++b)
#pragma unroll
                for (int m = 0; m < 4; ++m)
#pragma unroll
                    for (int n = 0; n < 2; ++n) acc[a][b][m][n] = (f32x4){0.f, 0.f, 0.f, 0.f};
        cur = nxt; cA = nA; cB = nB; ++ui;
        if constexpr (ALIGN_EPI) { if (wr == 1) PG8_BAR; }
    }
    PG8_WAIT_V(0);
    if constexpr (!ALIGN_EPI) { if (wr == 0) PG8_BAR; }
    PG8_BAR;
    if constexpr (Epi::AFTER_DRAIN) { E.fused(acc, cur, wr, wc, fr, fq, lds, wid, lane); S.done(cur); }
#undef PG8_SA
#undef PG8_SB
#undef PG8_STAGE
#undef PG8_LDA
#undef PG8_LDB
#undef PG8_MMA
#undef PG8_WAIT_V
#undef PG8_WAIT_L
#undef PG8_BAR
#undef PG8_SCHED
}
}

constexpr int NWAVES = 8;
constexpr int BATCH = 4, SEQ = 8192, D = 1024, M = BATCH * SEQ, DIN = 5120, FF = 4096, PLE = 256, AW = 512, NH = 8, HD = 64;
constexpr float EPS = 1e-6f;
constexpr int C_Q = 0, C_K = 512, C_V = 1024, C_CB = 1536, C_CC = 2048, C_CU = 2560, C_GA = 3072, C_GC = 4096;
constexpr size_t MiB = 1u << 20;
constexpr size_t WS_WIN = 1 * MiB, WS_WA = 11 * MiB, WS_WC = 12 * MiB, WS_WO = 13 * MiB, WS_WUP = 15 * MiB, WS_WDN = 23 * MiB, WS_WPG = 31 * MiB, WS_WPP = 33 * MiB;
constexpr size_t WS_R1 = 34 * MiB;
constexpr size_t WS_R2 = 98 * MiB;
constexpr size_t WS_R3 = 162 * MiB;
constexpr size_t WS_PB = 482 * MiB;
constexpr size_t WS_END = 498 * MiB;
constexpr int RING_BYTES = 131072, LDS_BYTES = 147456;

#define GAS __attribute__((address_space(1)))
#define LAS __attribute__((address_space(3)))
typedef unsigned short bf16;
typedef unsigned v4u __attribute__((ext_vector_type(4)));
typedef unsigned v2u __attribute__((ext_vector_type(2)));
typedef float f32x4 __attribute__((ext_vector_type(4)));
typedef float f32x16 __attribute__((ext_vector_type(16)));
typedef short bf16x8 __attribute__((ext_vector_type(8)));
using pg8::pk_bf16; using pg8::bf_lo; using pg8::bf_hi;
#define LDS_WAIT() asm volatile("s_waitcnt lgkmcnt(0)" ::: "memory")

__device__ __forceinline__ float wave_sum(float v) {
#pragma unroll
    for (int o = 1; o < 64; o <<= 1) v += __shfl_xor(v, o);
    return v;
}
__device__ __forceinline__ void p0_transpose_item(const float* W, int K, int N, bf16* WT, LAS float* scr, int item, int lane) {
    const int nblk = N / 32, kb = item / nblk, nb = item % nblk, k0 = 64 * kb, n0 = 32 * nb;
#pragma unroll 8
    for (int i = 0; i < 32; ++i) { const int kk = 2 * i + (lane >> 5); scr[kk * 33 + (lane & 31)] = W[(size_t)(k0 + kk) * N + n0 + (lane & 31)]; }
    LDS_WAIT(); asm volatile("" ::: "memory");
    const int c = lane & 7;
#pragma unroll
    for (int j = 0; j < 4; ++j) { const int n = (lane >> 3) + 8 * j; const LAS float* s = scr + (8 * c) * 33 + n;
        v4u o; o.x = pk_bf16(s[0 * 33], s[1 * 33]); o.y = pk_bf16(s[2 * 33], s[3 * 33]); o.z = pk_bf16(s[4 * 33], s[5 * 33]); o.w = pk_bf16(s[6 * 33], s[7 * 33]);
        *(v4u*)(WT + (size_t)(n0 + n) * K + k0 + 8 * c) = o; }
    LDS_WAIT(); asm volatile("" ::: "memory");
}
__device__ __forceinline__ void rms_row_to_bf16(const float* xrow, const float* g, bf16* orow, int lane) {
    const f32x4* xr = (const f32x4*)xrow + lane; const f32x4* gr = (const f32x4*)g + lane;
    f32x4 v[4]; float s = 0.f;
#pragma unroll
    for (int j = 0; j < 4; ++j) { v[j] = xr[64 * j]; s += (v[j].x * v[j].x + v[j].y * v[j].y) + (v[j].z * v[j].z + v[j].w * v[j].w); }
    const float rstd = 1.0f / sqrtf(wave_sum(s) * (1.f / D) + EPS);
    v2u* o8 = (v2u*)orow + lane;
#pragma unroll
    for (int j = 0; j < 4; ++j) { const f32x4 gg = gr[64 * j]; v2u w; w.x = pk_bf16(v[j].x * rstd * gg.x, v[j].y * rstd * gg.y); w.y = pk_bf16(v[j].z * rstd * gg.z, v[j].w * rstd * gg.w); o8[64 * j] = w; }
}
__device__ __forceinline__ void res_norm_row(const bf16* yrow, const float* base, float* out, const float* g1, const float* g2, bf16* xn, int lane) {
    const v2u* yr = (const v2u*)yrow + lane; const f32x4* br = (const f32x4*)base + lane; const f32x4* g1r = (const f32x4*)g1 + lane; const f32x4* g2r = (const f32x4*)g2 + lane;
    f32x4 y[4], x[4]; float s = 0.f;
#pragma unroll
    for (int j = 0; j < 4; ++j) { const v2u w = yr[64 * j]; y[j] = (f32x4){bf_lo(w.x), bf_hi(w.x), bf_lo(w.y), bf_hi(w.y)}; x[j] = br[64 * j];
        s += (y[j].x * y[j].x + y[j].y * y[j].y) + (y[j].z * y[j].z + y[j].w * y[j].w); }
    const float rstd = 1.0f / sqrtf(wave_sum(s) * (1.f / D) + EPS);
    float s2 = 0.f;
#pragma unroll
    for (int j = 0; j < 4; ++j) { const f32x4 gg = g1r[64 * j]; x[j] = x[j] + y[j] * rstd * gg; s2 += (x[j].x * x[j].x + x[j].y * x[j].y) + (x[j].z * x[j].z + x[j].w * x[j].w); }
    f32x4* orow = (f32x4*)out + lane;
#pragma unroll
    for (int j = 0; j < 4; ++j) orow[64 * j] = x[j];
    const float rstd2 = 1.0f / sqrtf(wave_sum(s2) * (1.f / D) + EPS);
    v2u* o8 = (v2u*)xn + lane;
#pragma unroll
    for (int j = 0; j < 4; ++j) { const f32x4 gg = g2r[64 * j]; v2u w; w.x = pk_bf16(x[j].x * rstd2 * gg.x, x[j].y * rstd2 * gg.y); w.y = pk_bf16(x[j].z * rstd2 * gg.z, x[j].w * rstd2 * gg.w); o8[64 * j] = w; }
}

#define MFMA32(a, b, c) __builtin_amdgcn_mfma_f32_32x32x16_bf16((a), (b), (c), 0, 0, 0)
__device__ __forceinline__ void attn_unit(const bf16* __restrict__ PROJ, bf16* __restrict__ O, int b, int h, int qt, int lane) {
    const int r = lane & 31, hh = lane >> 5;
    const size_t rowbase = (size_t)b * SEQ;
    const int t0 = qt * 32;
    const bf16* qp = PROJ + (rowbase + t0 + r) * DIN + C_Q + h * HD + 8 * hh;
    bf16x8 qf[4];
#pragma unroll
    for (int ds = 0; ds < 4; ++ds) qf[ds] = *(const bf16x8*)(qp + 16 * ds);
    f32x16 o0, o1;
#pragma unroll
    for (int i = 0; i < 16; ++i) { o0[i] = 0.f; o1[i] = 0.f; }
    float A = 0.f;
    const float L2E = 1.4426950408889634f, LN2 = 0.6931471805599453f;
    for (int kb = qt; kb >= 0; --kb) {
        const int k0 = kb * 32;
        const bf16* kp = PROJ + (rowbase + k0 + r) * DIN + C_K + h * HD + 8 * hh;
        bf16x8 kf[4];
#pragma unroll
        for (int ds = 0; ds < 4; ++ds) kf[ds] = *(const bf16x8*)(kp + 16 * ds);
        const bf16* vp = PROJ + (rowbase + k0 + 4 * hh) * DIN + C_V + h * HD + r;
        bf16x8 va[2][2];
#pragma unroll
        for (int s = 0; s < 2; ++s)
#pragma unroll
            for (int dh = 0; dh < 2; ++dh)
#pragma unroll
                for (int j = 0; j < 8; ++j) va[s][dh][j] = (short)vp[(size_t)(16 * s + 8 * (j >> 2) + (j & 3)) * DIN + 32 * dh];
        f32x16 st;
#pragma unroll
        for (int i = 0; i < 16; ++i) st[i] = 0.f;
#pragma unroll
        for (int ds = 0; ds < 4; ++ds) st = MFMA32(kf[ds], qf[ds], st);
        const bool diag = (kb == qt);
        float lk[16], lb[16];
#pragma unroll
        for (int i = 0; i < 16; ++i) {
            const float z = st[i] * 0.125f;
            const float e = __builtin_amdgcn_exp2f(-fabsf(z) * L2E);
            const float l = __builtin_amdgcn_logf(1.0f + e) * LN2;
            lb[i] = fminf(z, 0.f) - l;
            lk[i] = -fmaxf(z, 0.f) - l;
            if (diag) { const int kk = (i & 3) + 8 * (i >> 2) + 4 * hh; if (!(kk < r)) { lk[i] = 0.f; lb[i] = -INFINITY; } }
        }
        float within[16], c[4], cp[4];
#pragma unroll
        for (int g = 0; g < 4; ++g) { const float s3 = lk[4 * g + 3], s2 = s3 + lk[4 * g + 2], s1 = s2 + lk[4 * g + 1]; c[g] = s1 + lk[4 * g];
            within[4 * g + 3] = 0.f; within[4 * g + 2] = s3; within[4 * g + 1] = s2; within[4 * g] = s1; }
#pragma unroll
        for (int g = 0; g < 4; ++g) cp[g] = __shfl_xor(c[g], 32);
        const float T0 = c[0] + cp[0], T1 = c[1] + cp[1], T2 = c[2] + cp[2], T3 = c[3] + cp[3];
        float suf[4]; suf[3] = 0.f; suf[2] = T3; suf[1] = T3 + T2; suf[0] = suf[1] + T1;
        const float total = suf[0] + T0;
        float w[16];
#pragma unroll
        for (int g = 0; g < 4; ++g) { const float base = A + suf[g] + (hh == 0 ? cp[g] : 0.f);
#pragma unroll
            for (int i = 0; i < 4; ++i) w[4 * g + i] = __builtin_amdgcn_exp2f((lb[4 * g + i] + (base + within[4 * g + i])) * L2E); }
        v4u p0, p1;
        p0.x = pk_bf16(w[0], w[1]); p0.y = pk_bf16(w[2], w[3]); p0.z = pk_bf16(w[4], w[5]); p0.w = pk_bf16(w[6], w[7]);
        p1.x = pk_bf16(w[8], w[9]); p1.y = pk_bf16(w[10], w[11]); p1.z = pk_bf16(w[12], w[13]); p1.w = pk_bf16(w[14], w[15]);
        const bf16x8 x0 = __builtin_bit_cast(bf16x8, p0), x1 = __builtin_bit_cast(bf16x8, p1);
        o0 = MFMA32(va[0][0], x0, o0); o0 = MFMA32(va[1][0], x1, o0);
        o1 = MFMA32(va[0][1], x0, o1); o1 = MFMA32(va[1][1], x1, o1);
        A += total;
        if (__builtin_amdgcn_ballot_w64(A > -88.0f) == 0ull) break;
    }
    bf16* op = O + (rowbase + t0 + r) * AW + h * HD + 4 * hh;
#pragma unroll
    for (int g = 0; g < 4; ++g) {
        v2u a; a.x = pk_bf16(o0[4 * g], o0[4 * g + 1]); a.y = pk_bf16(o0[4 * g + 2], o0[4 * g + 3]); *(v2u*)(op + 8 * g) = a;
        v2u c2; c2.x = pk_bf16(o1[4 * g], o1[4 * g + 1]); c2.y = pk_bf16(o1[4 * g + 2], o1[4 * g + 3]); *(v2u*)(op + 32 + 8 * g) = c2;
    }
}
__device__ __forceinline__ void conv_item(const bf16* __restrict__ PROJ, const float* __restrict__ wconv, bf16* __restrict__ CM, int it) {
    const int cgp = it & 63, run = it >> 6, c0 = cgp * 8; const int t_start = run * 16; const bool first = (t_start % SEQ) == 0;
    f32x4 w0a = *(const f32x4*)(wconv + c0), w0b = *(const f32x4*)(wconv + c0 + 4), w1a = *(const f32x4*)(wconv + AW + c0), w1b = *(const f32x4*)(wconv + AW + c0 + 4),
          w2a = *(const f32x4*)(wconv + 2 * AW + c0), w2b = *(const f32x4*)(wconv + 2 * AW + c0 + 4);
    f32x4 m2a = {0.f, 0.f, 0.f, 0.f}, m2b = m2a, m1a = m2a, m1b = m2a;
    if (!first) {
        f32x4 a0, a1, b0, b1;
        pg8::unpack8(*(const v4u*)(PROJ + (size_t)(t_start - 2) * DIN + C_CC + c0), a0, a1); pg8::unpack8(*(const v4u*)(PROJ + (size_t)(t_start - 2) * DIN + C_CU + c0), b0, b1); m2a = a0 * b0; m2b = a1 * b1;
        pg8::unpack8(*(const v4u*)(PROJ + (size_t)(t_start - 1) * DIN + C_CC + c0), a0, a1); pg8::unpack8(*(const v4u*)(PROJ + (size_t)(t_start - 1) * DIN + C_CU + c0), b0, b1); m1a = a0 * b0; m1b = a1 * b1;
    }
#pragma unroll 4
    for (int t = 0; t < 16; ++t) {
        const bf16* rowp = PROJ + (size_t)(t_start + t) * DIN + c0;
        f32x4 a0, a1, b0, b1, g0, g1;
        pg8::unpack8(*(const v4u*)(rowp + C_CC), a0, a1); pg8::unpack8(*(const v4u*)(rowp + C_CU), b0, b1); pg8::unpack8(*(const v4u*)(rowp + C_CB), g0, g1);
        const f32x4 ma = a0 * b0, mb = a1 * b1;
        const f32x4 ra = g0 * (w0a * m2a + w1a * m1a + w2a * ma), rb = g1 * (w0b * m2b + w1b * m1b + w2b * mb);
        *(v4u*)(CM + (size_t)(t_start + t) * AW + c0) = pg8::pack8(ra, rb);
        m2a = m1a; m2b = m1b; m1a = ma; m1b = mb;
    }
}

struct Args { const float* in[17]; float* out; unsigned char* ws; int ph_lo, ph_hi; };
__global__ void __launch_bounds__(NWAVES * 64, 2) fwd_megakernel(Args args) {
    extern __shared__ __attribute__((aligned(16))) unsigned char lds_raw[];
    LAS unsigned char* lds = (LAS unsigned char*)lds_raw;
    cg::grid_group grid = cg::this_grid();
    const int tid = threadIdx.x, lane = tid & 63, wave = __builtin_amdgcn_readfirstlane(tid >> 6);
    const int G = gridDim.x, bx = blockIdx.x;
    const int gw = bx * NWAVES + wave, NGW = G * NWAVES;
    unsigned char* ws = args.ws;
    const float* x = args.in[0]; const float* p = args.in[1]; const float* g_pre_mix = args.in[2]; const float* w_in = args.in[3]; const float* b_gate = args.in[4];
    const float* w_conv = args.in[5]; const float* w_attn_out = args.in[6]; const float* w_conv_out = args.in[7]; const float* w_o = args.in[8]; const float* g_post_mix = args.in[9];
    const float* g_pre_mlp = args.in[10]; const float* w_up = args.in[11]; const float* w_down = args.in[12]; const float* g_post_mlp = args.in[13]; const float* g_ple = args.in[14];
    const float* w_ple_gate = args.in[15]; const float* w_ple_proj = args.in[16];
    float* out = args.out;
    bf16* Win_t = (bf16*)(ws + WS_WIN); bf16* Wa_t = (bf16*)(ws + WS_WA); bf16* Wc_t = (bf16*)(ws + WS_WC); bf16* Wo_t = (bf16*)(ws + WS_WO);
    bf16* Wup_t = (bf16*)(ws + WS_WUP); bf16* Wdn_t = (bf16*)(ws + WS_WDN); bf16* Wpg_t = (bf16*)(ws + WS_WPG); bf16* Wpp_t = (bf16*)(ws + WS_WPP);
    bf16* R1 = (bf16*)(ws + WS_R1); bf16* R2 = (bf16*)(ws + WS_R2); bf16* R3 = (bf16*)(ws + WS_R3); bf16* PB = (bf16*)(ws + WS_PB);
    bf16* XN = R1; bf16* MB = R1; bf16* Y6 = R1; bf16* GB = R1;
    bf16* OB = R2; bf16* CM = R2 + (size_t)M * AW; bf16* XN2 = R2; bf16* XN3 = R2;
    bf16* PROJ = R3; bf16* Y4 = R3; bf16* HB = R3;
    const int lo = args.ph_lo, hi = args.ph_hi;
#define IN(k) (lo <= (k) && (k) < hi)
#define SEAM(k) do { if (IN(k) && IN((k) + 1)) grid.sync(); } while (0)

    if (IN(0)) {
        LAS float* scr = (LAS float*)(lds + wave * 16384);
        constexpr int I_IN = (D / 64) * (DIN / 32), I_A = (AW / 64) * (D / 32), I_O = (D / 64) * (D / 32), I_UP = (D / 64) * (FF / 32), I_DN = (FF / 64) * (D / 32), I_PP = (PLE / 64) * (D / 32);
        constexpr int NITEMS = I_IN + 2 * I_A + 2 * I_O + I_UP + I_DN + I_PP;
        for (int it = gw; it < NITEMS; it += NGW) {
            int r = it;
            if (r < I_IN) { p0_transpose_item(w_in, D, DIN, Win_t, scr, r, lane); continue; } r -= I_IN;
            if (r < I_A) { p0_transpose_item(w_attn_out, AW, D, Wa_t, scr, r, lane); continue; } r -= I_A;
            if (r < I_A) { p0_transpose_item(w_conv_out, AW, D, Wc_t, scr, r, lane); continue; } r -= I_A;
            if (r < I_O) { p0_transpose_item(w_o, D, D, Wo_t, scr, r, lane); continue; } r -= I_O;
            if (r < I_UP) { p0_transpose_item(w_up, D, FF, Wup_t, scr, r, lane); continue; } r -= I_UP;
            if (r < I_DN) { p0_transpose_item(w_down, FF, D, Wdn_t, scr, r, lane); continue; } r -= I_DN;
            if (r < I_O) { p0_transpose_item(w_ple_gate, D, D, Wpg_t, scr, r, lane); continue; } r -= I_O;
            p0_transpose_item(w_ple_proj, PLE, D, Wpp_t, scr, r, lane);
        }
        for (int m = gw; m < M; m += NGW) rms_row_to_bf16(x + (size_t)m * D, g_pre_mix, XN + (size_t)m * D, lane);
        for (int i = bx * (NWAVES * 64) + tid; i < M * PLE / 8; i += G * NWAVES * 64) {
            const f32x4 a = *(const f32x4*)(p + (size_t)i * 8), b2 = *(const f32x4*)(p + (size_t)i * 8 + 4);
            *(v4u*)(PB + (size_t)i * 8) = pg8::pack8(a, b2);
        }
        __syncthreads();
    }
    SEAM(0);
    if (IN(1)) {
        pg8::Gemm g{XN, Win_t, M, DIN, D}; pg8::StaticOrder S; S.init(M, DIN, G, bx);
        pg8::EpiTile8<pg8::FProj> E{{PROJ, b_gate}};
        pg8::gemm_phase<pg8::EpiTile8<pg8::FProj>, pg8::StaticOrder, true, true>(lds, g, S, E);
    }
    SEAM(1);
    if (IN(2)) {
        constexpr int NQT = SEQ / 32, NUNITS = BATCH * NH * NQT;
        for (int u = gw; u < NUNITS; u += NGW) { const int qt = u % NQT, bh = u / NQT; attn_unit(PROJ, OB, bh / NH, bh % NH, qt, lane); }
        for (int it = bx * (NWAVES * 64) + tid; it < (M / 16) * 64; it += G * NWAVES * 64) conv_item(PROJ, w_conv, CM, it);
        __syncthreads();
    }
    SEAM(2);
    if (IN(3)) {
        { pg8::Gemm g{OB, Wa_t, M, D, AW}; pg8::StaticOrder S; S.init(M, D, G, bx);
          pg8::EpiTile8<pg8::FMixA> E{{MB, PROJ + C_GA}};
          pg8::gemm_phase<pg8::EpiTile8<pg8::FMixA>, pg8::StaticOrder, true, true>(lds, g, S, E); }
        { pg8::Gemm g{CM, Wc_t, M, D, AW}; pg8::StaticOrder S; S.init(M, D, G, bx);
          pg8::EpiTile8<pg8::FMixC> E{{MB, PROJ + C_GC}};
          pg8::gemm_phase<pg8::EpiTile8<pg8::FMixC>, pg8::StaticOrder, true, true>(lds, g, S, E); }
    }
    SEAM(3);
    if (IN(4)) {
        pg8::Gemm g{MB, Wo_t, M, D, D}; pg8::StaticOrder S; S.init(M, D, G, bx);
        pg8::EpiTile8<pg8::FStore<0>> E{{Y4, D}};
        pg8::gemm_phase<pg8::EpiTile8<pg8::FStore<0>>, pg8::StaticOrder, true, true>(lds, g, S, E);
    }
    SEAM(4);
    if (IN(5)) {
        for (int m = gw; m < M; m += NGW) res_norm_row(Y4 + (size_t)m * D, x + (size_t)m * D, out + (size_t)m * D, g_post_mix, g_pre_mlp, XN2 + (size_t)m * D, lane);
        __syncthreads();
    }
    SEAM(5);
    if (IN(6)) {
        pg8::Gemm g{XN2, Wup_t, M, FF, D}; pg8::StaticOrder S; S.init(M, FF, G, bx);
        pg8::EpiTile8<pg8::FStore<1>> E{{HB, FF}};
        pg8::gemm_phase<pg8::EpiTile8<pg8::FStore<1>>, pg8::StaticOrder, true, true>(lds, g, S, E);
    }
    SEAM(6);
    if (IN(7)) {
        pg8::Gemm g{HB, Wdn_t, M, D, FF}; pg8::StaticOrder S; S.init(M, D, G, bx);
        pg8::EpiTile8<pg8::FStore<0>> E{{Y6, D}};
        pg8::gemm_phase<pg8::EpiTile8<pg8::FStore<0>>, pg8::StaticOrder, true, true>(lds, g, S, E);
    }
    SEAM(7);
    if (IN(8)) {
        for (int m = gw; m < M; m += NGW) res_norm_row(Y6 + (size_t)m * D, out + (size_t)m * D, out + (size_t)m * D, g_post_mlp, g_ple, XN3 + (size_t)m * D, lane);
        __syncthreads();
    }
    SEAM(8);
    if (IN(9)) {
        { pg8::Gemm g{XN3, Wpg_t, M, D, D}; pg8::StaticOrder S; S.init(M, D, G, bx);
          pg8::EpiTile8<pg8::FStore<2>> E{{GB, D}};
          pg8::gemm_phase<pg8::EpiTile8<pg8::FStore<2>>, pg8::StaticOrder, true, true>(lds, g, S, E); }
        { pg8::Gemm g{PB, Wpp_t, M, D, PLE}; pg8::StaticOrder S; S.init(M, D, G, bx);
          pg8::EpiTile8<pg8::FFinal> E{{out, GB}};
          pg8::gemm_phase<pg8::EpiTile8<pg8::FFinal>, pg8::StaticOrder, true, true>(lds, g, S, E); }
    }
#undef IN
#undef SEAM
}

#ifndef MK_N_LAUNCHES
#define MK_N_LAUNCHES 1
#endif
constexpr int N_PHASES = 10;
extern "C" void kernel_launch(void* const* d_in, const int* in_sizes, int n_in, void* d_out, int out_size, void* d_ws, size_t ws_size, hipStream_t stream) {
    static int grid = 0;
    if (grid == 0) {
        if (n_in != 17 || in_sizes[0] != M * D || out_size != M * D || ws_size < WS_END) { fprintf(stderr, "kernel_launch: unexpected shapes (n_in %d, in0 %d, out %d, ws %zu)\n", n_in, n_in > 0 ? in_sizes[0] : -1, out_size, ws_size); grid = -1; return; }
        int dev = 0, cus = 0, per_cu = 0;
        hipGetDevice(&dev); hipDeviceGetAttribute(&cus, hipDeviceAttributeMultiprocessorCount, dev);
        if (hipFuncSetAttribute((const void*)fwd_megakernel, hipFuncAttributeMaxDynamicSharedMemorySize, LDS_BYTES) != hipSuccess) { fprintf(stderr, "kernel_launch: hipFuncSetAttribute failed\n"); grid = -1; return; }
        if (hipOccupancyMaxActiveBlocksPerMultiprocessor(&per_cu, (const void*)fwd_megakernel, NWAVES * 64, LDS_BYTES) != hipSuccess || per_cu < 1) { fprintf(stderr, "kernel_launch: occupancy query says %d\n", per_cu); per_cu = 1; }
        (void)hipGetLastError();
        grid = cus * per_cu;
        fprintf(stderr, "kernel_launch: grid %d (cus %d x %d)\n", grid, cus, per_cu);
    }
    if (grid < 0) return;
    Args a{};
    for (int i = 0; i < 17; ++i) a.in[i] = (const float*)d_in[i];
    a.out = (float*)d_out; a.ws = (unsigned char*)d_ws;
#if MK_N_LAUNCHES == 1
    a.ph_lo = 0; a.ph_hi = N_PHASES;
    void* kargs[] = {&a};
    hipError_t e = hipLaunchCooperativeKernel((const void*)fwd_megakernel, dim3(grid), dim3(NWAVES * 64), kargs, LDS_BYTES, stream);
    if (e != hipSuccess) fprintf(stderr, "cooperative launch failed: %s (grid %d)\n", hipGetErrorString(e), grid);
#else
    for (int ph = 0; ph < N_PHASES; ++ph) { a.ph_lo = ph; a.ph_hi = ph + 1; hipLaunchKernelGGL(fwd_megakernel, dim3(grid), dim3(NWAVES * 64), LDS_BYTES, stream, a); }
#endif
}
```

```cpp
#include <hip/hip_runtime.h>
#include <hip/hip_cooperative_groups.h>
#include <cstdio>
#include <cstdint>
namespace cg = cooperative_groups;
namespace pg8 {
#define PG8_LAS __attribute__((address_space(3)))
typedef unsigned short bf16_t;
typedef short bf16x8 __attribute__((ext_vector_type(8)));
typedef float f32x4 __attribute__((ext_vector_type(4)));
typedef unsigned u32x4 __attribute__((ext_vector_type(4)));
constexpr int BM = 256, BK = 64, HALF = 128, HTB = HALF * BK * 2  , STAGE_BYTES = 8 * HTB, NXCD = 8, WGM = 8;

__host__ __device__ __forceinline__ int lds_byte(int r, int c) { const int st = (r >> 4) * 2 + (c >> 5), rr = r & 15, cc = c & 31, ob = rr * 64 + cc * 2; return st * 1024 + (ob ^ (((ob >> 9) & 1) << 5)); }
__host__ __device__ __forceinline__ void stage_rc(int b, int& R, int& C) { const int st = b / 1024, sb = b % 1024, swz = sb ^ (((sb >> 9) & 1) << 5); R = (st >> 1) * 16 + swz / 64; C = (st & 1) * 32 + (swz % 64) / 2; }
__host__ __device__ __forceinline__ int perm32(int rho) { const int n = rho >> 4, i = rho & 15; return 8 * (i >> 2) + 4 * n + (i & 3); }

struct Unit { int pm, pn; };
struct Gemm { const bf16_t* A; const bf16_t* Bt; int M, N, K; };

struct StaticOrder {
    int nM, nN, nwg, G, c;
    __host__ __device__ void init(int M, int N, int G_, int c_) { nM = M / BM; nN = N / BM; nwg = nM * nN; G = G_; c = c_; }
    __host__ __device__ bool next(int i, Unit& u) const {
        const long L = (long)i * G + c; if (L >= nwg) return false;
        int wgid = (int)L; { const int q = nwg / NXCD, r = nwg % NXCD, xcd = wgid % NXCD, off = wgid / NXCD; wgid = (xcd < r ? xcd * (q + 1) : r * (q + 1) + (xcd - r) * q) + off; }
        const int nig = WGM * nN, gid = wgid / nig, fm = gid * WGM, gsz = (nM - fm) < WGM ? (nM - fm) : WGM;
        u.pm = fm + ((wgid % nig) % gsz); u.pn = (wgid % nig) / gsz; return true;
    }
    __device__ __forceinline__ void a_ready(const Unit&) const {}
    __device__ __forceinline__ void done(const Unit&) const {}
};

__device__ __forceinline__ unsigned cvt_pk_bf16(float lo, float hi) { unsigned r; asm volatile("v_cvt_pk_bf16_f32 %0, %1, %2" : "=v"(r) : "v"(lo), "v"(hi)); return r; }
typedef float f32x2 __attribute__((ext_vector_type(2)));
typedef __bf16 bf16x2_t __attribute__((ext_vector_type(2)));
__device__ __forceinline__ unsigned pk_bf16(float lo, float hi) { f32x2 v = {lo, hi}; bf16x2_t b = __builtin_convertvector(v, bf16x2_t); return __builtin_bit_cast(unsigned, b); }
__device__ __forceinline__ float bf_lo(unsigned w) { return __uint_as_float(w << 16); }
__device__ __forceinline__ float bf_hi(unsigned w) { return __uint_as_float(w & 0xffff0000u); }
__device__ __forceinline__ float sigmoidf_fast(float x) { return __builtin_amdgcn_rcpf(1.0f + __builtin_amdgcn_exp2f(-1.4426950408889634f * x)); }
__device__ __forceinline__ u32x4 pack8(const f32x4 a, const f32x4 b) { u32x4 w; w.x = pk_bf16(a[0], a[1]); w.y = pk_bf16(a[2], a[3]); w.z = pk_bf16(b[0], b[1]); w.w = pk_bf16(b[2], b[3]); return w; }
__device__ __forceinline__ void unpack8(const u32x4 w, f32x4& a, f32x4& b) { a = (f32x4){bf_lo(w.x), bf_hi(w.x), bf_lo(w.y), bf_hi(w.y)}; b = (f32x4){bf_lo(w.z), bf_hi(w.z), bf_lo(w.w), bf_hi(w.w)}; }

template <class F> struct EpiTile8 {
    static constexpr bool PERM = true, AFTER_DRAIN = false;
    F f;
    __device__ __forceinline__ void operator()(const f32x4 (&acc)[2][2][4][2], const Unit& u, int wr, int wc, int fr, int fq) const {
        const int row0 = u.pm * BM + wr * 64 + fr, col0 = u.pn * BM + wc * 32 + 8 * fq;
#pragma unroll
        for (int ai = 0; ai < 2; ++ai)
#pragma unroll
            for (int m = 0; m < 4; ++m)
#pragma unroll
                for (int bj = 0; bj < 2; ++bj) f(row0 + ai * HALF + m * 16, col0 + bj * HALF, u.pn, acc[ai][bj][m][0], acc[ai][bj][m][1]);
    }
};
struct FProj { bf16_t* O; const float* bgate;
    __device__ __forceinline__ void operator()(int row, int col, int pn, f32x4 v0, f32x4 v1) const {
        if (pn >= 12) { const f32x4 b0 = *(const f32x4*)(bgate + col - 3072), b1 = *(const f32x4*)(bgate + col - 3072 + 4);
#pragma unroll
            for (int i = 0; i < 4; ++i) { v0[i] = sigmoidf_fast(v0[i] + b0[i]); v1[i] = sigmoidf_fast(v1[i] + b1[i]); } }
        *(u32x4*)(O + (size_t)row * 5120 + col) = pack8(v0, v1); } };
struct FMixA { bf16_t* MB; const bf16_t* G;
    __device__ __forceinline__ void operator()(int row, int col, int, f32x4 v0, f32x4 v1) const {
        f32x4 g0, g1; unpack8(*(const u32x4*)(G + (size_t)row * 5120 + col), g0, g1);
        *(u32x4*)(MB + (size_t)row * 1024 + col) = pack8(v0 * g0, v1 * g1); } };
struct FMixC { bf16_t* MB; const bf16_t* G;
    __device__ __forceinline__ void operator()(int row, int col, int, f32x4 v0, f32x4 v1) const {
        f32x4 g0, g1, m0, m1; unpack8(*(const u32x4*)(G + (size_t)row * 5120 + col), g0, g1); unpack8(*(const u32x4*)(MB + (size_t)row * 1024 + col), m0, m1);
        *(u32x4*)(MB + (size_t)row * 1024 + col) = pack8(m0 + v0 * g0, m1 + v1 * g1); } };
template <int ACT  > struct FStore { bf16_t* O; int ldc;
    __device__ __forceinline__ void operator()(int row, int col, int, f32x4 v0, f32x4 v1) const {
        if (ACT == 1) {
#pragma unroll
            for (int i = 0; i < 4; ++i) { const float a = fmaxf(v0[i], 0.f), b = fmaxf(v1[i], 0.f); v0[i] = a * a; v1[i] = b * b; } }
        if (ACT == 2) {
#pragma unroll
            for (int i = 0; i < 4; ++i) { v0[i] = sigmoidf_fast(v0[i]); v1[i] = sigmoidf_fast(v1[i]); } }
        *(u32x4*)(O + (size_t)row * ldc + col) = pack8(v0, v1); } };
struct FFinal { float* out; const bf16_t* GB;
    __device__ __forceinline__ void operator()(int row, int col, int, f32x4 v0, f32x4 v1) const {
        f32x4 g0, g1; unpack8(*(const u32x4*)(GB + (size_t)row * 1024 + col), g0, g1);
        float* p = out + (size_t)row * 1024 + col; const f32x4 x0 = *(const f32x4*)p, x1 = *(const f32x4*)(p + 4);
        *(f32x4*)p = x0 + g0 * v0; *(f32x4*)(p + 4) = x1 + g1 * v1; } };

template <class Epi, class Sched, bool ALIGN_EPI = false, bool SP2 = false>
__device__ __forceinline__ void gemm_phase(PG8_LAS unsigned char* lds, const Gemm g, const Sched& S, const Epi& E) {
    const int tid = threadIdx.x, wid = __builtin_amdgcn_readfirstlane(tid >> 6), lane = tid & 63, wr = wid >> 2, wc = wid & 3, fr = lane & 15, fq = lane >> 4;
    const int K = g.K, nt = K / BK;
    unsigned voffA[2], voffB[2];
#pragma unroll
    for (int i = 0; i < 2; ++i) { int R, C; stage_rc(tid * 16 + i * 8192, R, C); const int Rb = Epi::PERM ? ((R & ~31) + perm32(R & 31)) : R;
        voffA[i] = (unsigned)(R * K + C) * 2u; voffB[i] = (unsigned)(Rb * K + C) * 2u; }
    const size_t kstep = (size_t)(BK * 2);
    const size_t hstep = (size_t)HALF * K * 2;
    const size_t tstep = 2 * hstep;
    const unsigned ldsw = (unsigned)wid * 1024u;
    const int aoff = lds_byte(wr * 64 + fr, fq * 8), boff = lds_byte(wc * 32 + fr, fq * 8);
#define PG8_SA(b, h) (((b) * 2 + (h)) * HTB)
#define PG8_SB(b, h) ((4 + (b) * 2 + (h)) * HTB)
#define PG8_STAGE(bufoff, gbase, voff) do { _Pragma("unroll") for (int _i = 0; _i < 2; ++_i) \
        __builtin_amdgcn_global_load_lds((const unsigned*)((const char*)(gbase) + (voff)[_i]), (PG8_LAS unsigned*)(lds + (bufoff) + ldsw + _i * 8192), 16, 0, 0); } while (0)
#define PG8_LDA(dst, b, h) do { _Pragma("unroll") for (int m = 0; m < 4; ++m) _Pragma("unroll") for (int k = 0; k < 2; ++k) dst[m][k] = *(const PG8_LAS bf16x8*)(lds + PG8_SA(b, h) + aoff + m * 2048 + k * 1024); } while (0)
#define PG8_LDB(dst, b, h) do { _Pragma("unroll") for (int n = 0; n < 2; ++n) _Pragma("unroll") for (int k = 0; k < 2; ++k) dst[n][k] = *(const PG8_LAS bf16x8*)(lds + PG8_SB(b, h) + boff + n * 2048 + k * 1024); } while (0)
#define PG8_MMA(ai, bj, At, Bt) do { __builtin_amdgcn_s_setprio(1); _Pragma("unroll") for (int m = 0; m < 4; ++m) _Pragma("unroll") for (int n = 0; n < 2; ++n) _Pragma("unroll") for (int k = 0; k < 2; ++k) \
        acc[ai][bj][m][n] = __builtin_amdgcn_mfma_f32_16x16x32_bf16(Bt[n][k], At[m][k], acc[ai][bj][m][n], 0, 0, 0); __builtin_amdgcn_s_setprio(0); } while (0)
#define PG8_WAIT_V(n) asm volatile("s_waitcnt vmcnt(" #n ")" ::: "memory")
#define PG8_WAIT_L(n) asm volatile("s_waitcnt lgkmcnt(" #n ")" ::: "memory")
#define PG8_BAR __builtin_amdgcn_s_barrier()
#define PG8_SCHED __builtin_amdgcn_sched_barrier(0)
    Unit cur, nxt; int ui = 0;
    if (!S.next(0, cur)) return;
    f32x4 acc[2][2][4][2];
#pragma unroll
    for (int a = 0; a < 2; ++a)
#pragma unroll
        for (int b = 0; b < 2; ++b)
#pragma unroll
            for (int m = 0; m < 4; ++m)
#pragma unroll
                for (int n = 0; n < 2; ++n) acc[a][b][m][n] = (f32x4){0.f, 0.f, 0.f, 0.f};
    bf16x8 At[4][2], B0[2][2], B1[2][2];
    const char* cA = (const char*)g.A + (size_t)cur.pm * tstep; const char* cB = (const char*)g.Bt + (size_t)cur.pn * tstep;
    S.a_ready(cur);
    if constexpr (SP2) {
        PG8_STAGE(PG8_SB(0, 0), cB, voffB); PG8_STAGE(PG8_SB(0, 1), cB + hstep, voffB); PG8_STAGE(PG8_SA(0, 0), cA, voffA); PG8_STAGE(PG8_SA(0, 1), cA + hstep, voffA);
        if (wr == 1) PG8_BAR;
        PG8_WAIT_V(2); PG8_BAR;
        PG8_STAGE(PG8_SB(1, 0), cB + kstep, voffB); PG8_STAGE(PG8_SA(1, 0), cA + kstep, voffA); PG8_STAGE(PG8_SB(1, 1), cB + hstep + kstep, voffB);
        PG8_WAIT_V(6); PG8_BAR;
    } else {
        PG8_STAGE(PG8_SB(0, 0), cB, voffB); PG8_STAGE(PG8_SA(0, 0), cA, voffA); PG8_STAGE(PG8_SB(0, 1), cB + hstep, voffB); PG8_STAGE(PG8_SA(0, 1), cA + hstep, voffA);
        if (wr == 1) PG8_BAR;
        PG8_WAIT_V(4); PG8_BAR;
        PG8_STAGE(PG8_SB(1, 0), cB + kstep, voffB); PG8_STAGE(PG8_SA(1, 0), cA + kstep, voffA); PG8_STAGE(PG8_SB(1, 1), cB + hstep + kstep, voffB);
        PG8_WAIT_V(6); PG8_BAR;
    }
    for (;;) {
        const bool has_next = S.next(ui + 1, nxt);
        const char* nA = has_next ? (const char*)g.A + (size_t)nxt.pm * tstep : cA; const char* nB = has_next ? (const char*)g.Bt + (size_t)nxt.pn * tstep : cB;
        for (int t = 0; t < nt; t += 2) {
            const bool last = (t == nt - 2);
            const char* a1 = cA + (size_t)(t + 1) * kstep;
            const char* a2 = last ? nA : cA + (size_t)(t + 2) * kstep; const char* b2 = last ? nB : cB + (size_t)(t + 2) * kstep;
            const char* a3 = a2 + kstep; const char* b3 = b2 + kstep;
            if (last && has_next) S.a_ready(nxt);
            if constexpr (SP2) {
            PG8_LDB(B0, 0, 0); PG8_LDB(B1, 0, 1); PG8_SCHED; PG8_LDA(At, 0, 0); PG8_STAGE(PG8_SA(1, 1), a1 + hstep, voffA);
            PG8_WAIT_V(8); PG8_WAIT_L(0); PG8_BAR; PG8_MMA(0, 0, At, B0); PG8_MMA(0, 1, At, B1); PG8_BAR; PG8_SCHED;
            PG8_LDA(At, 0, 1); PG8_STAGE(PG8_SB(0, 0), b2, voffB); PG8_STAGE(PG8_SB(0, 1), b2 + hstep, voffB); PG8_STAGE(PG8_SA(0, 0), a2, voffA);
            PG8_WAIT_V(8); PG8_WAIT_L(0); PG8_BAR; PG8_MMA(1, 0, At, B0); PG8_MMA(1, 1, At, B1); PG8_BAR; PG8_SCHED;
            PG8_LDB(B0, 1, 0); PG8_LDB(B1, 1, 1); PG8_SCHED; PG8_LDA(At, 1, 0); PG8_STAGE(PG8_SA(0, 1), a2 + hstep, voffA);
            PG8_WAIT_V(8); PG8_WAIT_L(0); PG8_BAR; PG8_MMA(0, 0, At, B0); PG8_MMA(0, 1, At, B1); PG8_BAR; PG8_SCHED;
            PG8_LDA(At, 1, 1); PG8_STAGE(PG8_SB(1, 0), b3, voffB); PG8_STAGE(PG8_SB(1, 1), b3 + hstep, voffB); PG8_STAGE(PG8_SA(1, 0), a3, voffA);
            PG8_WAIT_V(8); PG8_WAIT_L(0); PG8_BAR; PG8_MMA(1, 0, At, B0); PG8_MMA(1, 1, At, B1); PG8_BAR; PG8_SCHED;
            } else {
            PG8_LDB(B0, 0, 0); PG8_SCHED; PG8_LDA(At, 0, 0); PG8_STAGE(PG8_SA(1, 1), a1 + hstep, voffA);
            PG8_WAIT_L(8); PG8_BAR; PG8_WAIT_L(0); PG8_MMA(0, 0, At, B0); PG8_BAR; PG8_SCHED;
            PG8_LDB(B1, 0, 1); PG8_STAGE(PG8_SB(0, 0), b2, voffB);
            PG8_BAR; PG8_WAIT_L(0); PG8_MMA(0, 1, At, B1); PG8_BAR;
            PG8_LDA(At, 0, 1); PG8_STAGE(PG8_SA(0, 0), a2, voffA);
            PG8_BAR; PG8_WAIT_L(0); PG8_MMA(1, 0, At, B0); PG8_BAR; PG8_SCHED;
            PG8_STAGE(PG8_SB(0, 1), b2 + hstep, voffB);
            PG8_WAIT_V(6); PG8_BAR; PG8_MMA(1, 1, At, B1); PG8_BAR;
            PG8_LDB(B0, 1, 0); PG8_SCHED; PG8_LDA(At, 1, 0); PG8_STAGE(PG8_SA(0, 1), a2 + hstep, voffA);
            PG8_WAIT_L(8); PG8_BAR; PG8_WAIT_L(0); PG8_MMA(0, 0, At, B0); PG8_BAR; PG8_SCHED;
            PG8_LDB(B1, 1, 1); PG8_STAGE(PG8_SB(1, 0), b3, voffB);
            PG8_BAR; PG8_WAIT_L(0); PG8_MMA(0, 1, At, B1); PG8_BAR;
            PG8_LDA(At, 1, 1); PG8_STAGE(PG8_SA(1, 0), a3, voffA);
            PG8_BAR; PG8_WAIT_L(0); PG8_MMA(1, 0, At, B0); PG8_BAR; PG8_SCHED;
            PG8_STAGE(PG8_SB(1, 1), b3 + hstep, voffB);
            PG8_WAIT_V(6); PG8_BAR; PG8_MMA(1, 1, At, B1); PG8_BAR;
            }
        }
        if constexpr (ALIGN_EPI) { if (wr == 0) PG8_BAR; }
        if constexpr (!Epi::AFTER_DRAIN) { E(acc, cur, wr, wc, fr, fq); S.done(cur); }
        if (!has_next) break;
#pragma unroll
        for (int a = 0; a < 2; ++a)
#pragma unroll
            for (int b = 0; b < 2; ++b)
#pragma unroll
                for (int m = 0; m < 4; ++m)
#pragma unroll
                    for (int n = 0; n < 2; ++n) acc[a][b][m][n] = (f32x4){0.f, 0.f, 0.f, 0.f};
        cur = nxt; cA = nA; cB = nB; ++ui;
        if constexpr (ALIGN_EPI) { if (wr == 1) PG8_BAR; }
    }
    PG8_WAIT_V(0);
    if constexpr (!ALIGN_EPI) { if (wr == 0) PG8_BAR; }
    PG8_BAR;
    if constexpr (Epi::AFTER_DRAIN) { E.fused(acc, cur, wr, wc, fr, fq, lds, wid, lane); S.done(cur); }
#undef PG8_SA
#undef PG8_SB
#undef PG8_STAGE
#undef PG8_LDA
#undef PG8_LDB
#undef PG8_MMA
#undef PG8_WAIT_V
#undef PG8_WAIT_L
#undef PG8_BAR
#undef PG8_SCHED
}
}

constexpr int NWAVES = 8;
constexpr int BATCH = 4, SEQ = 8192, D = 1024, M = BATCH * SEQ, DIN = 5120, FF = 4096, PLE = 256, AW = 512, NH = 8, HD = 64;
constexpr float EPS = 1e-6f;
constexpr int C_Q = 0, C_K = 512, C_V = 1024, C_CB = 1536, C_CC = 2048, C_CU = 2560, C_GA = 3072, C_GC = 4096;
constexpr size_t MiB = 1u << 20;
constexpr size_t WS_WIN = 1 * MiB, WS_WA = 11 * MiB, WS_WC = 12 * MiB, WS_WO = 13 * MiB, WS_WUP = 15 * MiB, WS_WDN = 23 * MiB, WS_WPG = 31 * MiB, WS_WPP = 33 * MiB;
constexpr size_t WS_R1 = 34 * MiB;
constexpr size_t WS_R2 = 98 * MiB;
constexpr size_t WS_R3 = 162 * MiB;
constexpr size_t WS_PB = 482 * MiB;
constexpr size_t WS_END = 498 * MiB;
constexpr int RING_BYTES = 131072, LDS_BYTES = 147456;

#define GAS __attribute__((address_space(1)))
#define LAS __attribute__((address_space(3)))
typedef unsigned short bf16;
typedef unsigned v4u __attribute__((ext_vector_type(4)));
typedef unsigned v2u __attribute__((ext_vector_type(2)));
typedef float f32x4 __attribute__((ext_vector_type(4)));
typedef float f32x16 __attribute__((ext_vector_type(16)));
typedef short bf16x8 __attribute__((ext_vector_type(8)));
using pg8::pk_bf16; using pg8::bf_lo; using pg8::bf_hi;
#define LDS_WAIT() asm volatile("s_waitcnt lgkmcnt(0)" ::: "memory")

#define XB_TMO      128
#define XB_XCNT(j)  (256  + 64 * (j))
#define XB_XSUB(j)  (1280 + 64 * (j))
#define XB_XGEN(j)  (2304 + 64 * (j))
#define XB_TOP      3328
#define XB_TOPGEN   3392
#define XCD_BAR_WORDS 3456
#define XB_SPIN_CAP (1u << 18)

__device__ __forceinline__ unsigned xb_ld(unsigned* p)              { return __hip_atomic_load(p, __ATOMIC_RELAXED, __HIP_MEMORY_SCOPE_AGENT); }
__device__ __forceinline__ unsigned xb_add(unsigned* p, unsigned v) { return __hip_atomic_fetch_add(p, v, __ATOMIC_RELAXED, __HIP_MEMORY_SCOPE_AGENT); }
__device__ __forceinline__ unsigned xb_xcc_id() { return (unsigned)__builtin_amdgcn_s_getreg((3 << 11) | 20) & 0xFu; }
#define XB_SPIN(cond, bar) do { unsigned _sp = 0; while (cond) { __builtin_amdgcn_s_sleep(1); \
    if ((++_sp & 255u) == 0u) { if (xb_ld(&(bar)[XB_TMO])) break; if (_sp > XB_SPIN_CAP) { atomicAdd(&(bar)[XB_TMO], 1u); break; } } } } while (0)

struct XcdBarrier {
    unsigned* bar; unsigned x;
    volatile LAS unsigned* st;
};

__device__ __forceinline__ XcdBarrier xcd_barrier_post(unsigned* bar, volatile LAS unsigned* st) {
    XcdBarrier b; b.bar = bar; b.x = xb_xcc_id(); b.st = st;
    if (threadIdx.x == 0) (void)xb_add(&bar[XB_XCNT(b.x)], 1u);
    return b;
}
__device__ __forceinline__ void xcd_barrier_complete(unsigned* bar, unsigned x, unsigned& nloc, unsigned& nx) {
    const unsigned G = gridDim.x * gridDim.y * gridDim.z;
    unsigned sum, cnt, mine, sp = 0u;
    for (;;) {
        sum = 0u; cnt = 0u; mine = 0u;
#pragma unroll
        for (unsigned j = 0; j < 16; ++j) { const unsigned c = xb_ld(&bar[XB_XCNT(j)]); sum += c; cnt += (c > 0u) ? 1u : 0u; mine = (j == x) ? c : mine; }
        if (sum == G) break;
        __builtin_amdgcn_s_sleep(1);
        if ((++sp & 255u) == 0u) { if (xb_ld(&bar[XB_TMO])) break; if (sp > XB_SPIN_CAP) { atomicAdd(&bar[XB_TMO], 1u); break; } }
    }
    nloc = mine > 0u ? mine : 1u; nx = cnt > 0u ? cnt : 1u;
}

__device__ __forceinline__ void xcd_barrier(const XcdBarrier& b) {
    asm volatile("s_waitcnt vmcnt(0)" ::: "memory");
    __syncthreads();
    if (threadIdx.x == 0) {
        unsigned* bar = b.bar;
        __builtin_amdgcn_s_waitcnt(0);
        unsigned nloc = b.st[0], nx = b.st[1];
        if (nloc == 0u) { xcd_barrier_complete(bar, b.x, nloc, nx); b.st[0] = nloc; b.st[1] = nx; }
        const unsigned old = xb_add(&bar[XB_XSUB(b.x)], 1u);
        const unsigned gen = old / nloc;
        if (old + 1u == (gen + 1u) * nloc) {
            __builtin_amdgcn_fence(__ATOMIC_RELEASE, "agent");
            asm volatile("s_waitcnt vmcnt(0)" ::: "memory");
            const unsigned og = xb_add(&bar[XB_TOP], 1u);
            const unsigned tg = og / nx;
            if (og + 1u == (tg + 1u) * nx) xb_add(&bar[XB_TOPGEN], 1u);
            else XB_SPIN(xb_ld(&bar[XB_TOPGEN]) == tg, bar);
            __builtin_amdgcn_fence(__ATOMIC_ACQUIRE, "agent");
            xb_add(&bar[XB_XGEN(b.x)], 1u);
            asm volatile("s_waitcnt vmcnt(0)" ::: "memory");
        } else {
            XB_SPIN(xb_ld(&bar[XB_XGEN(b.x)]) == gen, bar);
            __builtin_amdgcn_fence(__ATOMIC_ACQUIRE, "agent");
            asm volatile("s_waitcnt vmcnt(0)" ::: "memory");
        }
    }
    __syncthreads();
}


__device__ __forceinline__ float wave_sum(float v) {
#pragma unroll
    for (int o = 1; o < 64; o <<= 1) v += __shfl_xor(v, o);
    return v;
}
__device__ __forceinline__ void p0_transpose_item(const float* W, int K, int N, bf16* WT, LAS float* scr, int item, int lane) {
    const int nblk = N / 32, kb = item / nblk, nb = item % nblk, k0 = 64 * kb, n0 = 32 * nb;
#pragma unroll 8
    for (int i = 0; i < 32; ++i) { const int kk = 2 * i + (lane >> 5); scr[kk * 33 + (lane & 31)] = W[(size_t)(k0 + kk) * N + n0 + (lane & 31)]; }
    LDS_WAIT(); asm volatile("" ::: "memory");
    const int c = lane & 7;
#pragma unroll
    for (int j = 0; j < 4; ++j) { const int n = (lane >> 3) + 8 * j; const LAS float* s = scr + (8 * c) * 33 + n;
        v4u o; o.x = pk_bf16(s[0 * 33], s[1 * 33]); o.y = pk_bf16(s[2 * 33], s[3 * 33]); o.z = pk_bf16(s[4 * 33], s[5 * 33]); o.w = pk_bf16(s[6 * 33], s[7 * 33]);
        *(v4u*)(WT + (size_t)(n0 + n) * K + k0 + 8 * c) = o; }
    LDS_WAIT(); asm volatile("" ::: "memory");
}
__device__ __forceinline__ void rms_row_to_bf16(const float* xrow, const float* g, bf16* orow, int lane) {
    const f32x4* xr = (const f32x4*)xrow + lane; const f32x4* gr = (const f32x4*)g + lane;
    f32x4 v[4]; float s = 0.f;
#pragma unroll
    for (int j = 0; j < 4; ++j) { v[j] = xr[64 * j]; s += (v[j].x * v[j].x + v[j].y * v[j].y) + (v[j].z * v[j].z + v[j].w * v[j].w); }
    const float rstd = 1.0f / sqrtf(wave_sum(s) * (1.f / D) + EPS);
    v2u* o8 = (v2u*)orow + lane;
#pragma unroll
    for (int j = 0; j < 4; ++j) { const f32x4 gg = gr[64 * j]; v2u w; w.x = pk_bf16(v[j].x * rstd * gg.x, v[j].y * rstd * gg.y); w.y = pk_bf16(v[j].z * rstd * gg.z, v[j].w * rstd * gg.w); o8[64 * j] = w; }
}
__device__ __forceinline__ void res_norm_row(const bf16* yrow, const float* base, float* out, const float* g1, const float* g2, bf16* xn, int lane) {
    const v2u* yr = (const v2u*)yrow + lane; const f32x4* br = (const f32x4*)base + lane; const f32x4* g1r = (const f32x4*)g1 + lane; const f32x4* g2r = (const f32x4*)g2 + lane;
    f32x4 y[4], x[4]; float s = 0.f;
#pragma unroll
    for (int j = 0; j < 4; ++j) { const v2u w = yr[64 * j]; y[j] = (f32x4){bf_lo(w.x), bf_hi(w.x), bf_lo(w.y), bf_hi(w.y)}; x[j] = br[64 * j];
        s += (y[j].x * y[j].x + y[j].y * y[j].y) + (y[j].z * y[j].z + y[j].w * y[j].w); }
    const float rstd = 1.0f / sqrtf(wave_sum(s) * (1.f / D) + EPS);
    float s2 = 0.f;
#pragma unroll
    for (int j = 0; j < 4; ++j) { const f32x4 gg = g1r[64 * j]; x[j] = x[j] + y[j] * rstd * gg; s2 += (x[j].x * x[j].x + x[j].y * x[j].y) + (x[j].z * x[j].z + x[j].w * x[j].w); }
    f32x4* orow = (f32x4*)out + lane;
#pragma unroll
    for (int j = 0; j < 4; ++j) orow[64 * j] = x[j];
    const float rstd2 = 1.0f / sqrtf(wave_sum(s2) * (1.f / D) + EPS);
    v2u* o8 = (v2u*)xn + lane;
#pragma unroll
    for (int j = 0; j < 4; ++j) { const f32x4 gg = g2r[64 * j]; v2u w; w.x = pk_bf16(x[j].x * rstd2 * gg.x, x[j].y * rstd2 * gg.y); w.y = pk_bf16(x[j].z * rstd2 * gg.z, x[j].w * rstd2 * gg.w); o8[64 * j] = w; }
}

#define MFMA32(a, b, c) __builtin_amdgcn_mfma_f32_32x32x16_bf16((a), (b), (c), 0, 0, 0)
__device__ __forceinline__ void attn_unit(const bf16* __restrict__ PROJ, bf16* __restrict__ O, int b, int h, int qt, int lane) {
    const int r = lane & 31, hh = lane >> 5;
    const size_t rowbase = (size_t)b * SEQ;
    const int t0 = qt * 32;
    const bf16* qp = PROJ + (rowbase + t0 + r) * DIN + C_Q + h * HD + 8 * hh;
    bf16x8 qf[4];
#pragma unroll
    for (int ds = 0; ds < 4; ++ds) qf[ds] = *(const bf16x8*)(qp + 16 * ds);
    f32x16 o0, o1;
#pragma unroll
    for (int i = 0; i < 16; ++i) { o0[i] = 0.f; o1[i] = 0.f; }
    float A = 0.f;
    const float L2E = 1.4426950408889634f, LN2 = 0.6931471805599453f;
    for (int kb = qt; kb >= 0; --kb) {
        const int k0 = kb * 32;
        const bf16* kp = PROJ + (rowbase + k0 + r) * DIN + C_K + h * HD + 8 * hh;
        bf16x8 kf[4];
#pragma unroll
        for (int ds = 0; ds < 4; ++ds) kf[ds] = *(const bf16x8*)(kp + 16 * ds);
        const bf16* vp = PROJ + (rowbase + k0 + 4 * hh) * DIN + C_V + h * HD + r;
        bf16x8 va[2][2];
#pragma unroll
        for (int s = 0; s < 2; ++s)
#pragma unroll
            for (int dh = 0; dh < 2; ++dh)
#pragma unroll
                for (int j = 0; j < 8; ++j) va[s][dh][j] = (short)vp[(size_t)(16 * s + 8 * (j >> 2) + (j & 3)) * DIN + 32 * dh];
        f32x16 st;
#pragma unroll
        for (int i = 0; i < 16; ++i) st[i] = 0.f;
#pragma unroll
        for (int ds = 0; ds < 4; ++ds) st = MFMA32(kf[ds], qf[ds], st);
        const bool diag = (kb == qt);
        float lk[16], lb[16];
#pragma unroll
        for (int i = 0; i < 16; ++i) {
            const float z = st[i] * 0.125f;
            const float e = __builtin_amdgcn_exp2f(-fabsf(z) * L2E);
            const float l = __builtin_amdgcn_logf(1.0f + e) * LN2;
            lb[i] = fminf(z, 0.f) - l;
            lk[i] = -fmaxf(z, 0.f) - l;
            if (diag) { const int kk = (i & 3) + 8 * (i >> 2) + 4 * hh; if (!(kk < r)) { lk[i] = 0.f; lb[i] = -INFINITY; } }
        }
        float within[16], c[4], cp[4];
#pragma unroll
        for (int g = 0; g < 4; ++g) { const float s3 = lk[4 * g + 3], s2 = s3 + lk[4 * g + 2], s1 = s2 + lk[4 * g + 1]; c[g] = s1 + lk[4 * g];
            within[4 * g + 3] = 0.f; within[4 * g + 2] = s3; within[4 * g + 1] = s2; within[4 * g] = s1; }
#pragma unroll
        for (int g = 0; g < 4; ++g) cp[g] = __shfl_xor(c[g], 32);
        const float T0 = c[0] + cp[0], T1 = c[1] + cp[1], T2 = c[2] + cp[2], T3 = c[3] + cp[3];
        float suf[4]; suf[3] = 0.f; suf[2] = T3; suf[1] = T3 + T2; suf[0] = suf[1] + T1;
        const float total = suf[0] + T0;
        float w[16];
#pragma unroll
        for (int g = 0; g < 4; ++g) { const float base = A + suf[g] + (hh == 0 ? cp[g] : 0.f);
#pragma unroll
            for (int i = 0; i < 4; ++i) w[4 * g + i] = __builtin_amdgcn_exp2f((lb[4 * g + i] + (base + within[4 * g + i])) * L2E); }
        v4u p0, p1;
        p0.x = pk_bf16(w[0], w[1]); p0.y = pk_bf16(w[2], w[3]); p0.z = pk_bf16(w[4], w[5]); p0.w = pk_bf16(w[6], w[7]);
        p1.x = pk_bf16(w[8], w[9]); p1.y = pk_bf16(w[10], w[11]); p1.z = pk_bf16(w[12], w[13]); p1.w = pk_bf16(w[14], w[15]);
        const bf16x8 x0 = __builtin_bit_cast(bf16x8, p0), x1 = __builtin_bit_cast(bf16x8, p1);
        o0 = MFMA32(va[0][0], x0, o0); o0 = MFMA32(va[1][0], x1, o0);
        o1 = MFMA32(va[0][1], x0, o1); o1 = MFMA32(va[1][1], x1, o1);
        A += total;
        if (__builtin_amdgcn_ballot_w64(A > -88.0f) == 0ull) break;
    }
    bf16* op = O + (rowbase + t0 + r) * AW + h * HD + 4 * hh;
#pragma unroll
    for (int g = 0; g < 4; ++g) {
        v2u a; a.x = pk_bf16(o0[4 * g], o0[4 * g + 1]); a.y = pk_bf16(o0[4 * g + 2], o0[4 * g + 3]); *(v2u*)(op + 8 * g) = a;
        v2u c2; c2.x = pk_bf16(o1[4 * g], o1[4 * g + 1]); c2.y = pk_bf16(o1[4 * g + 2], o1[4 * g + 3]); *(v2u*)(op + 32 + 8 * g) = c2;
    }
}
__device__ __forceinline__ void conv_item(const bf16* __restrict__ PROJ, const float* __restrict__ wconv, bf16* __restrict__ CM, int it) {
    const int cgp = it & 63, run = it >> 6, c0 = cgp * 8; const int t_start = run * 16; const bool first = (t_start % SEQ) == 0;
    f32x4 w0a = *(const f32x4*)(wconv + c0), w0b = *(const f32x4*)(wconv + c0 + 4), w1a = *(const f32x4*)(wconv + AW + c0), w1b = *(const f32x4*)(wconv + AW + c0 + 4),
          w2a = *(const f32x4*)(wconv + 2 * AW + c0), w2b = *(const f32x4*)(wconv + 2 * AW + c0 + 4);
    f32x4 m2a = {0.f, 0.f, 0.f, 0.f}, m2b = m2a, m1a = m2a, m1b = m2a;
    if (!first) {
        f32x4 a0, a1, b0, b1;
        pg8::unpack8(*(const v4u*)(PROJ + (size_t)(t_start - 2) * DIN + C_CC + c0), a0, a1); pg8::unpack8(*(const v4u*)(PROJ + (size_t)(t_start - 2) * DIN + C_CU + c0), b0, b1); m2a = a0 * b0; m2b = a1 * b1;
        pg8::unpack8(*(const v4u*)(PROJ + (size_t)(t_start - 1) * DIN + C_CC + c0), a0, a1); pg8::unpack8(*(const v4u*)(PROJ + (size_t)(t_start - 1) * DIN + C_CU + c0), b0, b1); m1a = a0 * b0; m1b = a1 * b1;
    }
#pragma unroll 4
    for (int t = 0; t < 16; ++t) {
        const bf16* rowp = PROJ + (size_t)(t_start + t) * DIN + c0;
        f32x4 a0, a1, b0, b1, g0, g1;
        pg8::unpack8(*(const v4u*)(rowp + C_CC), a0, a1); pg8::unpack8(*(const v4u*)(rowp + C_CU), b0, b1); pg8::unpack8(*(const v4u*)(rowp + C_CB), g0, g1);
        const f32x4 ma = a0 * b0, mb = a1 * b1;
        const f32x4 ra = g0 * (w0a * m2a + w1a * m1a + w2a * ma), rb = g1 * (w0b * m2b + w1b * m1b + w2b * mb);
        *(v4u*)(CM + (size_t)(t_start + t) * AW + c0) = pg8::pack8(ra, rb);
        m2a = m1a; m2b = m1b; m1a = ma; m1b = mb;
    }
}

struct Args { const float* in[17]; float* out; unsigned char* ws; int ph_lo, ph_hi; };
__global__ void __launch_bounds__(NWAVES * 64, 2) fwd_megakernel(Args args) {
    extern __shared__ __attribute__((aligned(16))) unsigned char lds_raw[];
    LAS unsigned char* lds = (LAS unsigned char*)lds_raw;
    cg::grid_group grid = cg::this_grid();
    const int tid = threadIdx.x, lane = tid & 63, wave = __builtin_amdgcn_readfirstlane(tid >> 6);
    const int G = gridDim.x, bx = blockIdx.x;
    const int gw = bx * NWAVES + wave, NGW = G * NWAVES;
    unsigned char* ws = args.ws;
    const float* x = args.in[0]; const float* p = args.in[1]; const float* g_pre_mix = args.in[2]; const float* w_in = args.in[3]; const float* b_gate = args.in[4];
    const float* w_conv = args.in[5]; const float* w_attn_out = args.in[6]; const float* w_conv_out = args.in[7]; const float* w_o = args.in[8]; const float* g_post_mix = args.in[9];
    const float* g_pre_mlp = args.in[10]; const float* w_up = args.in[11]; const float* w_down = args.in[12]; const float* g_post_mlp = args.in[13]; const float* g_ple = args.in[14];
    const float* w_ple_gate = args.in[15]; const float* w_ple_proj = args.in[16];
    float* out = args.out;
    bf16* Win_t = (bf16*)(ws + WS_WIN); bf16* Wa_t = (bf16*)(ws + WS_WA); bf16* Wc_t = (bf16*)(ws + WS_WC); bf16* Wo_t = (bf16*)(ws + WS_WO);
    bf16* Wup_t = (bf16*)(ws + WS_WUP); bf16* Wdn_t = (bf16*)(ws + WS_WDN); bf16* Wpg_t = (bf16*)(ws + WS_WPG); bf16* Wpp_t = (bf16*)(ws + WS_WPP);
    bf16* R1 = (bf16*)(ws + WS_R1); bf16* R2 = (bf16*)(ws + WS_R2); bf16* R3 = (bf16*)(ws + WS_R3); bf16* PB = (bf16*)(ws + WS_PB);
    bf16* XN = R1; bf16* MB = R1; bf16* Y6 = R1; bf16* GB = R1;
    bf16* OB = R2; bf16* CM = R2 + (size_t)M * AW; bf16* XN2 = R2; bf16* XN3 = R2;
    bf16* PROJ = R3; bf16* Y4 = R3; bf16* HB = R3;
    const int lo = args.ph_lo, hi = args.ph_hi;
    volatile LAS unsigned* bst = (volatile LAS unsigned*)(lds + RING_BYTES + 384);
    if (tid < 2) bst[tid] = 0u;
    __syncthreads();
    if (lo < 0) grid.sync();
    XcdBarrier bar; bar.bar = (unsigned*)ws; bar.x = 0; bar.st = bst;
    if (hi - lo > 1) bar = xcd_barrier_post((unsigned*)ws, bst);
#ifndef PROBE_DUP_MASK
#define PROBE_DUP_MASK 0
#endif
#ifndef PROBE_DUP_SYNC
#define PROBE_DUP_SYNC 0
#endif
#define IN(k) (lo <= (k) && (k) < hi)
#define REP(k) for (int rep_ = 0; rep_ < (((PROBE_DUP_MASK >> (k)) & 1) ? 2 : 1); ++rep_)
#define SEAM(k) do { if (IN(k) && IN((k) + 1)) { xcd_barrier(bar); if (PROBE_DUP_SYNC) xcd_barrier(bar); } } while (0)

    if (IN(0)) REP(0) {
        LAS float* scr = (LAS float*)(lds + wave * 16384);
        constexpr int I_IN = (D / 64) * (DIN / 32), I_A = (AW / 64) * (D / 32), I_O = (D / 64) * (D / 32), I_UP = (D / 64) * (FF / 32), I_DN = (FF / 64) * (D / 32), I_PP = (PLE / 64) * (D / 32);
        constexpr int NITEMS = I_IN + 2 * I_A + 2 * I_O + I_UP + I_DN + I_PP;
        for (int it = gw; it < NITEMS; it += NGW) {
            int r = it;
            if (r < I_IN) { p0_transpose_item(w_in, D, DIN, Win_t, scr, r, lane); continue; } r -= I_IN;
            if (r < I_A) { p0_transpose_item(w_attn_out, AW, D, Wa_t, scr, r, lane); continue; } r -= I_A;
            if (r < I_A) { p0_transpose_item(w_conv_out, AW, D, Wc_t, scr, r, lane); continue; } r -= I_A;
            if (r < I_O) { p0_transpose_item(w_o, D, D, Wo_t, scr, r, lane); continue; } r -= I_O;
            if (r < I_UP) { p0_transpose_item(w_up, D, FF, Wup_t, scr, r, lane); continue; } r -= I_UP;
            if (r < I_DN) { p0_transpose_item(w_down, FF, D, Wdn_t, scr, r, lane); continue; } r -= I_DN;
            if (r < I_O) { p0_transpose_item(w_ple_gate, D, D, Wpg_t, scr, r, lane); continue; } r -= I_O;
            p0_transpose_item(w_ple_proj, PLE, D, Wpp_t, scr, r, lane);
        }
        for (int m = gw; m < M; m += NGW) rms_row_to_bf16(x + (size_t)m * D, g_pre_mix, XN + (size_t)m * D, lane);
        for (int i = bx * (NWAVES * 64) + tid; i < M * PLE / 8; i += G * NWAVES * 64) {
            const f32x4 a = *(const f32x4*)(p + (size_t)i * 8), b2 = *(const f32x4*)(p + (size_t)i * 8 + 4);
            *(v4u*)(PB + (size_t)i * 8) = pg8::pack8(a, b2);
        }
        __syncthreads();
    }
    SEAM(0);
    if (IN(1)) REP(1) {
        pg8::Gemm g{XN, Win_t, M, DIN, D}; pg8::StaticOrder S; S.init(M, DIN, G, bx);
        pg8::EpiTile8<pg8::FProj> E{{PROJ, b_gate}};
        pg8::gemm_phase<pg8::EpiTile8<pg8::FProj>, pg8::StaticOrder, true, true>(lds, g, S, E);
    }
    SEAM(1);
    if (IN(2)) REP(2) {
        constexpr int NQT = SEQ / 32, NUNITS = BATCH * NH * NQT;
        for (int u = gw; u < NUNITS; u += NGW) { const int qt = u % NQT, bh = u / NQT; attn_unit(PROJ, OB, bh / NH, bh % NH, qt, lane); }
        for (int it = bx * (NWAVES * 64) + tid; it < (M / 16) * 64; it += G * NWAVES * 64) conv_item(PROJ, w_conv, CM, it);
        __syncthreads();
    }
    SEAM(2);
    if (IN(3)) REP(3) {
        { pg8::Gemm g{OB, Wa_t, M, D, AW}; pg8::StaticOrder S; S.init(M, D, G, bx);
          pg8::EpiTile8<pg8::FMixA> E{{MB, PROJ + C_GA}};
          pg8::gemm_phase<pg8::EpiTile8<pg8::FMixA>, pg8::StaticOrder, true, true>(lds, g, S, E); }
        { pg8::Gemm g{CM, Wc_t, M, D, AW}; pg8::StaticOrder S; S.init(M, D, G, bx);
          pg8::EpiTile8<pg8::FMixC> E{{MB, PROJ + C_GC}};
          pg8::gemm_phase<pg8::EpiTile8<pg8::FMixC>, pg8::StaticOrder, true, true>(lds, g, S, E); }
    }
    SEAM(3);
    if (IN(4)) REP(4) {
        pg8::Gemm g{MB, Wo_t, M, D, D}; pg8::StaticOrder S; S.init(M, D, G, bx);
        pg8::EpiTile8<pg8::FStore<0>> E{{Y4, D}};
        pg8::gemm_phase<pg8::EpiTile8<pg8::FStore<0>>, pg8::StaticOrder, true, true>(lds, g, S, E);
    }
    SEAM(4);
    if (IN(5)) REP(5) {
        for (int m = gw; m < M; m += NGW) res_norm_row(Y4 + (size_t)m * D, x + (size_t)m * D, out + (size_t)m * D, g_post_mix, g_pre_mlp, XN2 + (size_t)m * D, lane);
        __syncthreads();
    }
    SEAM(5);
    if (IN(6)) REP(6) {
        pg8::Gemm g{XN2, Wup_t, M, FF, D}; pg8::StaticOrder S; S.init(M, FF, G, bx);
        pg8::EpiTile8<pg8::FStore<1>> E{{HB, FF}};
        pg8::gemm_phase<pg8::EpiTile8<pg8::FStore<1>>, pg8::StaticOrder, true, true>(lds, g, S, E);
    }
    SEAM(6);
    if (IN(7)) REP(7) {
        pg8::Gemm g{HB, Wdn_t, M, D, FF}; pg8::StaticOrder S; S.init(M, D, G, bx);
        pg8::EpiTile8<pg8::FStore<0>> E{{Y6, D}};
        pg8::gemm_phase<pg8::EpiTile8<pg8::FStore<0>>, pg8::StaticOrder, true, true>(lds, g, S, E);
    }
    SEAM(7);
    if (IN(8)) REP(8) {
        for (int m = gw; m < M; m += NGW) res_norm_row(Y6 + (size_t)m * D, out + (size_t)m * D, out + (size_t)m * D, g_post_mlp, g_ple, XN3 + (size_t)m * D, lane);
        __syncthreads();
    }
    SEAM(8);
    if (IN(9)) REP(9) {
        { pg8::Gemm g{XN3, Wpg_t, M, D, D}; pg8::StaticOrder S; S.init(M, D, G, bx);
          pg8::EpiTile8<pg8::FStore<2>> E{{GB, D}};
          pg8::gemm_phase<pg8::EpiTile8<pg8::FStore<2>>, pg8::StaticOrder, true, true>(lds, g, S, E); }
        { pg8::Gemm g{PB, Wpp_t, M, D, PLE}; pg8::StaticOrder S; S.init(M, D, G, bx);
          pg8::EpiTile8<pg8::FFinal> E{{out, GB}};
          pg8::gemm_phase<pg8::EpiTile8<pg8::FFinal>, pg8::StaticOrder, true, true>(lds, g, S, E); }
    }
#undef IN
#undef SEAM
}

#ifndef MK_N_LAUNCHES
#define MK_N_LAUNCHES 1
#endif
constexpr int N_PHASES = 10;
extern "C" void kernel_launch(void* const* d_in, const int* in_sizes, int n_in, void* d_out, int out_size, void* d_ws, size_t ws_size, hipStream_t stream) {
    static int grid = 0;
    if (grid == 0) {
        if (n_in != 17 || in_sizes[0] != M * D || out_size != M * D || ws_size < WS_END) { fprintf(stderr, "kernel_launch: unexpected shapes (n_in %d, in0 %d, out %d, ws %zu)\n", n_in, n_in > 0 ? in_sizes[0] : -1, out_size, ws_size); grid = -1; return; }
        int dev = 0, cus = 0, per_cu = 0;
        hipGetDevice(&dev); hipDeviceGetAttribute(&cus, hipDeviceAttributeMultiprocessorCount, dev);
        if (hipFuncSetAttribute((const void*)fwd_megakernel, hipFuncAttributeMaxDynamicSharedMemorySize, LDS_BYTES) != hipSuccess) { fprintf(stderr, "kernel_launch: hipFuncSetAttribute failed\n"); grid = -1; return; }
        if (hipOccupancyMaxActiveBlocksPerMultiprocessor(&per_cu, (const void*)fwd_megakernel, NWAVES * 64, LDS_BYTES) != hipSuccess || per_cu < 1) { fprintf(stderr, "kernel_launch: occupancy query says %d\n", per_cu); per_cu = 1; }
        (void)hipGetLastError();
        grid = cus * per_cu;
        fprintf(stderr, "kernel_launch: grid %d (cus %d x %d)\n", grid, cus, per_cu);
    }
    if (grid < 0) return;
    Args a{};
    for (int i = 0; i < 17; ++i) a.in[i] = (const float*)d_in[i];
    a.out = (float*)d_out; a.ws = (unsigned char*)d_ws;
#if MK_N_LAUNCHES == 1
    a.ph_lo = 0; a.ph_hi = N_PHASES;
    if (hipMemsetAsync(d_ws, 0, 65536, stream) != hipSuccess) { fprintf(stderr, "kernel_launch: memset failed\n"); return; }
    void* kargs[] = {&a};
    hipError_t e = hipLaunchCooperativeKernel((const void*)fwd_megakernel, dim3(grid), dim3(NWAVES * 64), kargs, LDS_BYTES, stream);
    if (e != hipSuccess) fprintf(stderr, "cooperative launch failed: %s (grid %d)\n", hipGetErrorString(e), grid);
#else
    for (int ph = 0; ph < N_PHASES; ++ph) { a.ph_lo = ph; a.ph_hi = ph + 1; hipLaunchKernelGGL(fwd_megakernel, dim3(grid), dim3(NWAVES * 64), LDS_BYTES, stream, a); }
#endif
}
```

```cpp
#include <hip/hip_runtime.h>
#include <hip/hip_cooperative_groups.h>
#include <cstdio>
#include <cstdint>
namespace cg = cooperative_groups;
namespace pg8 {
#define PG8_LAS __attribute__((address_space(3)))
typedef unsigned short bf16_t;
typedef short bf16x8 __attribute__((ext_vector_type(8)));
typedef float f32x4 __attribute__((ext_vector_type(4)));
typedef unsigned u32x4 __attribute__((ext_vector_type(4)));
constexpr int BM = 256, BK = 64, HALF = 128, HTB = HALF * BK * 2  , STAGE_BYTES = 8 * HTB, NXCD = 8, WGM = 8;

__host__ __device__ __forceinline__ int lds_byte(int r, int c) { const int st = (r >> 4) * 2 + (c >> 5), rr = r & 15, cc = c & 31, ob = rr * 64 + cc * 2; return st * 1024 + (ob ^ (((ob >> 9) & 1) << 5)); }
__host__ __device__ __forceinline__ void stage_rc(int b, int& R, int& C) { const int st = b / 1024, sb = b % 1024, swz = sb ^ (((sb >> 9) & 1) << 5); R = (st >> 1) * 16 + swz / 64; C = (st & 1) * 32 + (swz % 64) / 2; }
__host__ __device__ __forceinline__ int perm32(int rho) { const int n = rho >> 4, i = rho & 15; return 8 * (i >> 2) + 4 * n + (i & 3); }

struct Unit { int pm, pn; };
struct Gemm { const bf16_t* A; const bf16_t* Bt; int M, N, K; };

struct StaticOrder {
    int nM, nN, nwg, G, c;
    __host__ __device__ void init(int M, int N, int G_, int c_) { nM = M / BM; nN = N / BM; nwg = nM * nN; G = G_; c = c_; }
    __host__ __device__ bool next(int i, Unit& u) const {
        const long L = (long)i * G + c; if (L >= nwg) return false;
        int wgid = (int)L; { const int q = nwg / NXCD, r = nwg % NXCD, xcd = wgid % NXCD, off = wgid / NXCD; wgid = (xcd < r ? xcd * (q + 1) : r * (q + 1) + (xcd - r) * q) + off; }
        const int nig = WGM * nN, gid = wgid / nig, fm = gid * WGM, gsz = (nM - fm) < WGM ? (nM - fm) : WGM;
        u.pm = fm + ((wgid % nig) % gsz); u.pn = (wgid % nig) / gsz; return true;
    }
    __device__ __forceinline__ void a_ready(const Unit&) const {}
    __device__ __forceinline__ void done(const Unit&) const {}
};

__device__ __forceinline__ unsigned cvt_pk_bf16(float lo, float hi) { unsigned r; asm volatile("v_cvt_pk_bf16_f32 %0, %1, %2" : "=v"(r) : "v"(lo), "v"(hi)); return r; }
typedef float f32x2 __attribute__((ext_vector_type(2)));
typedef __bf16 bf16x2_t __attribute__((ext_vector_type(2)));
__device__ __forceinline__ unsigned pk_bf16(float lo, float hi) { f32x2 v = {lo, hi}; bf16x2_t b = __builtin_convertvector(v, bf16x2_t); return __builtin_bit_cast(unsigned, b); }
__device__ __forceinline__ float bf_lo(unsigned w) { return __uint_as_float(w << 16); }
__device__ __forceinline__ float bf_hi(unsigned w) { return __uint_as_float(w & 0xffff0000u); }
__device__ __forceinline__ float sigmoidf_fast(float x) { return __builtin_amdgcn_rcpf(1.0f + __builtin_amdgcn_exp2f(-1.4426950408889634f * x)); }
__device__ __forceinline__ u32x4 pack8(const f32x4 a, const f32x4 b) { u32x4 w; w.x = pk_bf16(a[0], a[1]); w.y = pk_bf16(a[2], a[3]); w.z = pk_bf16(b[0], b[1]); w.w = pk_bf16(b[2], b[3]); return w; }
__device__ __forceinline__ void unpack8(const u32x4 w, f32x4& a, f32x4& b) { a = (f32x4){bf_lo(w.x), bf_hi(w.x), bf_lo(w.y), bf_hi(w.y)}; b = (f32x4){bf_lo(w.z), bf_hi(w.z), bf_lo(w.w), bf_hi(w.w)}; }

template <class F> struct EpiTile8 {
    static constexpr bool PERM = true, AFTER_DRAIN = false;
    F f;
    __device__ __forceinline__ void operator()(const f32x4 (&acc)[2][2][4][2], const Unit& u, int wr, int wc, int fr, int fq) const {
        const int row0 = u.pm * BM + wr * 64 + fr, col0 = u.pn * BM + wc * 32 + 8 * fq;
#pragma unroll
        for (int ai = 0; ai < 2; ++ai)
#pragma unroll
            for (int m = 0; m < 4; ++m)
#pragma unroll
                for (int bj = 0; bj < 2; ++bj) f(row0 + ai * HALF + m * 16, col0 + bj * HALF, u.pn, acc[ai][bj][m][0], acc[ai][bj][m][1]);
    }
};
struct FProj { bf16_t* O; const float* bgate;
    __device__ __forceinline__ void operator()(int row, int col, int pn, f32x4 v0, f32x4 v1) const {
        if (pn >= 12) { const f32x4 b0 = *(const f32x4*)(bgate + col - 3072), b1 = *(const f32x4*)(bgate + col - 3072 + 4);
#pragma unroll
            for (int i = 0; i < 4; ++i) { v0[i] = sigmoidf_fast(v0[i] + b0[i]); v1[i] = sigmoidf_fast(v1[i] + b1[i]); } }
        *(u32x4*)(O + (size_t)row * 5120 + col) = pack8(v0, v1); } };
struct FMixA { bf16_t* MB; const bf16_t* G;
    __device__ __forceinline__ void operator()(int row, int col, int, f32x4 v0, f32x4 v1) const {
        f32x4 g0, g1; unpack8(*(const u32x4*)(G + (size_t)row * 5120 + col), g0, g1);
        *(u32x4*)(MB + (size_t)row * 1024 + col) = pack8(v0 * g0, v1 * g1); } };
struct FMixC { bf16_t* MB; const bf16_t* G;
    __device__ __forceinline__ void operator()(int row, int col, int, f32x4 v0, f32x4 v1) const {
        f32x4 g0, g1, m0, m1; unpack8(*(const u32x4*)(G + (size_t)row * 5120 + col), g0, g1); unpack8(*(const u32x4*)(MB + (size_t)row * 1024 + col), m0, m1);
        *(u32x4*)(MB + (size_t)row * 1024 + col) = pack8(m0 + v0 * g0, m1 + v1 * g1); } };
template <int ACT  > struct FStore { bf16_t* O; int ldc;
    __device__ __forceinline__ void operator()(int row, int col, int, f32x4 v0, f32x4 v1) const {
        if (ACT == 1) {
#pragma unroll
            for (int i = 0; i < 4; ++i) { const float a = fmaxf(v0[i], 0.f), b = fmaxf(v1[i], 0.f); v0[i] = a * a; v1[i] = b * b; } }
        if (ACT == 2) {
#pragma unroll
            for (int i = 0; i < 4; ++i) { v0[i] = sigmoidf_fast(v0[i]); v1[i] = sigmoidf_fast(v1[i]); } }
        *(u32x4*)(O + (size_t)row * ldc + col) = pack8(v0, v1); } };
struct FFinal { float* out; const bf16_t* GB;
    __device__ __forceinline__ void operator()(int row, int col, int, f32x4 v0, f32x4 v1) const {
        f32x4 g0, g1; unpack8(*(const u32x4*)(GB + (size_t)row * 1024 + col), g0, g1);
        float* p = out + (size_t)row * 1024 + col; const f32x4 x0 = *(const f32x4*)p, x1 = *(const f32x4*)(p + 4);
        *(f32x4*)p = x0 + g0 * v0; *(f32x4*)(p + 4) = x1 + g1 * v1; } };

struct PanelRms {
    unsigned* xbuf;
    unsigned* cnt;
    float eps;
    __device__ __forceinline__ void run(const f32x4 (&v)[2][2][4][2], const Unit& u, int wr, int wc, int fr, int fq, PG8_LAS unsigned char* tb, int wid, int lane) const {
        PG8_LAS float* P = (PG8_LAS float*)tb;
        PG8_LAS float* S = (PG8_LAS float*)(tb + 4096);
#pragma unroll
        for (int ai = 0; ai < 2; ++ai)
#pragma unroll
            for (int m = 0; m < 4; ++m) {
                float s = 0.f;
#pragma unroll
                for (int bj = 0; bj < 2; ++bj)
#pragma unroll
                    for (int n = 0; n < 2; ++n) { const f32x4 x = v[ai][bj][m][n]; s += (x[0] * x[0] + x[1] * x[1]) + (x[2] * x[2] + x[3] * x[3]); }
                s += __shfl_xor(s, 16); s += __shfl_xor(s, 32);
                if (fq == 0) P[(ai * HALF + wr * 64 + m * 16 + fr) * 4 + wc] = s;
            }
        asm volatile("s_waitcnt lgkmcnt(0)" ::: "memory"); __builtin_amdgcn_s_barrier(); asm volatile("" ::: "memory");
        const int row = wid * 32 + (lane & 31);
        if (lane < 32) {
            const f32x4 a = *(const PG8_LAS f32x4*)(P + row * 4);
            __hip_atomic_store(xbuf + ((size_t)(u.pm * BM + row) * 4 + u.pn), __float_as_uint((a[0] + a[1]) + (a[2] + a[3])), __ATOMIC_RELAXED, __HIP_MEMORY_SCOPE_AGENT);
        }
        asm volatile("s_waitcnt vmcnt(0)" ::: "memory");
        if (lane == 0) __hip_atomic_fetch_add(cnt + 64 * u.pm, 1u, __ATOMIC_RELAXED, __HIP_MEMORY_SCOPE_AGENT);
        if (wid == 0) {
            unsigned sp = 0;
            while ((unsigned)__builtin_amdgcn_readfirstlane(__hip_atomic_load(cnt + 64 * u.pm, __ATOMIC_RELAXED, __HIP_MEMORY_SCOPE_AGENT)) < 32u) { __builtin_amdgcn_s_sleep(2); if (++sp > (1u << 22)) break; }
            __builtin_amdgcn_fence(__ATOMIC_ACQUIRE, "agent");
        }
        asm volatile("s_waitcnt vmcnt(0) lgkmcnt(0)" ::: "memory"); __builtin_amdgcn_s_barrier(); asm volatile("" ::: "memory");
        if (lane < 32) {
            const unsigned* slot = xbuf + (size_t)(u.pm * BM + row) * 4; float t = 0.f;
#pragma unroll
            for (int k = 0; k < 4; ++k) t += __uint_as_float(__hip_atomic_load(slot + k, __ATOMIC_RELAXED, __HIP_MEMORY_SCOPE_AGENT));
            S[row] = 1.0f / sqrtf(t * (1.0f / 1024.0f) + eps);
        }
        asm volatile("s_waitcnt lgkmcnt(0)" ::: "memory"); __builtin_amdgcn_s_barrier(); asm volatile("" ::: "memory");
    }
};
struct EpiRmsResRms {
    static constexpr bool PERM = true, AFTER_DRAIN = false;
    const float* base; float* out; bf16_t* xn; const float* g1; const float* g2; PanelRms st1, st2; PG8_LAS unsigned char* tb;
    __device__ __forceinline__ void operator()(f32x4 (&acc)[2][2][4][2], const Unit& u, int wr, int wc, int fr, int fq) const {
        const int wid = wr * 4 + wc, lane = fq * 16 + fr;
        const PG8_LAS float* S = (const PG8_LAS float*)(tb + 4096);
        const int col0 = u.pn * BM + wc * 32 + 8 * fq;
        st1.run(acc, u, wr, wc, fr, fq, tb, wid, lane);
        {
            f32x4 gv[2][2];
#pragma unroll
            for (int bj = 0; bj < 2; ++bj) { gv[bj][0] = *(const f32x4*)(g1 + col0 + bj * HALF); gv[bj][1] = *(const f32x4*)(g1 + col0 + bj * HALF + 4); }
#pragma unroll
            for (int ai = 0; ai < 2; ++ai)
#pragma unroll
                for (int m = 0; m < 4; ++m) { const int r = ai * HALF + wr * 64 + m * 16 + fr; const float rs = S[r]; const float* bp = base + (size_t)(u.pm * BM + r) * 1024 + col0;
#pragma unroll
                    for (int bj = 0; bj < 2; ++bj)
#pragma unroll
                        for (int n = 0; n < 2; ++n) { const f32x4 bs = *(const f32x4*)(bp + bj * HALF + 4 * n); acc[ai][bj][m][n] = bs + acc[ai][bj][m][n] * rs * gv[bj][n]; }
                    asm volatile("" : "+v"(acc[ai][0][m][0]), "+v"(acc[ai][0][m][1]), "+v"(acc[ai][1][m][0]), "+v"(acc[ai][1][m][1]));
                    if (m & 1) asm volatile("" ::: "memory"); }
        }
        st2.run(acc, u, wr, wc, fr, fq, tb, wid, lane);
        {
            f32x4 gv[2][2];
#pragma unroll
            for (int bj = 0; bj < 2; ++bj) { gv[bj][0] = *(const f32x4*)(g2 + col0 + bj * HALF); gv[bj][1] = *(const f32x4*)(g2 + col0 + bj * HALF + 4); }
#pragma unroll
            for (int ai = 0; ai < 2; ++ai)
#pragma unroll
                for (int m = 0; m < 4; ++m) { const int r = ai * HALF + wr * 64 + m * 16 + fr; const float rs = S[r]; const size_t off = (size_t)(u.pm * BM + r) * 1024 + col0;
#pragma unroll
                    for (int bj = 0; bj < 2; ++bj) { const f32x4 a = acc[ai][bj][m][0], b = acc[ai][bj][m][1];
                        *(f32x4*)(out + off + bj * HALF) = a; *(f32x4*)(out + off + bj * HALF + 4) = b;
                        *(u32x4*)(xn + off + bj * HALF) = pack8(a * rs * gv[bj][0], b * rs * gv[bj][1]); }
                    asm volatile("" ::: "memory"); }
        }
    }
};

template <class Epi, class Sched, bool ALIGN_EPI = false, bool SP2 = false>
__device__ __forceinline__ void gemm_phase(PG8_LAS unsigned char* lds, const Gemm g, const Sched& S, const Epi& E) {
    const int tid = threadIdx.x, wid = __builtin_amdgcn_readfirstlane(tid >> 6), lane = tid & 63, wr = wid >> 2, wc = wid & 3, fr = lane & 15, fq = lane >> 4;
    const int K = g.K, nt = K / BK;
    unsigned voffA[2], voffB[2];
#pragma unroll
    for (int i = 0; i < 2; ++i) { int R, C; stage_rc(tid * 16 + i * 8192, R, C); const int Rb = Epi::PERM ? ((R & ~31) + perm32(R & 31)) : R;
        voffA[i] = (unsigned)(R * K + C) * 2u; voffB[i] = (unsigned)(Rb * K + C) * 2u; }
    const size_t kstep = (size_t)(BK * 2);
    const size_t hstep = (size_t)HALF * K * 2;
    const size_t tstep = 2 * hstep;
    const unsigned ldsw = (unsigned)wid * 1024u;
    const int aoff = lds_byte(wr * 64 + fr, fq * 8), boff = lds_byte(wc * 32 + fr, fq * 8);
#define PG8_SA(b, h) (((b) * 2 + (h)) * HTB)
#define PG8_SB(b, h) ((4 + (b) * 2 + (h)) * HTB)
#define PG8_STAGE(bufoff, gbase, voff) do { _Pragma("unroll") for (int _i = 0; _i < 2; ++_i) \
        __builtin_amdgcn_global_load_lds((const unsigned*)((const char*)(gbase) + (voff)[_i]), (PG8_LAS unsigned*)(lds + (bufoff) + ldsw + _i * 8192), 16, 0, 0); } while (0)
#define PG8_LDA(dst, b, h) do { _Pragma("unroll") for (int m = 0; m < 4; ++m) _Pragma("unroll") for (int k = 0; k < 2; ++k) dst[m][k] = *(const PG8_LAS bf16x8*)(lds + PG8_SA(b, h) + aoff + m * 2048 + k * 1024); } while (0)
#define PG8_LDB(dst, b, h) do { _Pragma("unroll") for (int n = 0; n < 2; ++n) _Pragma("unroll") for (int k = 0; k < 2; ++k) dst[n][k] = *(const PG8_LAS bf16x8*)(lds + PG8_SB(b, h) + boff + n * 2048 + k * 1024); } while (0)
#define PG8_MMA(ai, bj, At, Bt) do { __builtin_amdgcn_s_setprio(1); _Pragma("unroll") for (int m = 0; m < 4; ++m) _Pragma("unroll") for (int n = 0; n < 2; ++n) _Pragma("unroll") for (int k = 0; k < 2; ++k) \
        acc[ai][bj][m][n] = __builtin_amdgcn_mfma_f32_16x16x32_bf16(Bt[n][k], At[m][k], acc[ai][bj][m][n], 0, 0, 0); __builtin_amdgcn_s_setprio(0); } while (0)
#define PG8_WAIT_V(n) asm volatile("s_waitcnt vmcnt(" #n ")" ::: "memory")
#define PG8_WAIT_L(n) asm volatile("s_waitcnt lgkmcnt(" #n ")" ::: "memory")
#define PG8_BAR __builtin_amdgcn_s_barrier()
#define PG8_SCHED __builtin_amdgcn_sched_barrier(0)
    Unit cur, nxt; int ui = 0;
    if (!S.next(0, cur)) return;
    f32x4 acc[2][2][4][2];
#pragma unroll
    for (int a = 0; a < 2; ++a)
#pragma unroll
        for (int b = 0; b < 2; ++b)
#pragma unroll
            for (int m = 0; m < 4; ++m)
#pragma unroll
                for (int n = 0; n < 2; ++n) acc[a][b][m][n] = (f32x4){0.f, 0.f, 0.f, 0.f};
    bf16x8 At[4][2], B0[2][2], B1[2][2];
    const char* cA = (const char*)g.A + (size_t)cur.pm * tstep; const char* cB = (const char*)g.Bt + (size_t)cur.pn * tstep;
    S.a_ready(cur);
    if constexpr (SP2) {
        PG8_STAGE(PG8_SB(0, 0), cB, voffB); PG8_STAGE(PG8_SB(0, 1), cB + hstep, voffB); PG8_STAGE(PG8_SA(0, 0), cA, voffA); PG8_STAGE(PG8_SA(0, 1), cA + hstep, voffA);
        if (wr == 1) PG8_BAR;
        PG8_WAIT_V(2); PG8_BAR;
        PG8_STAGE(PG8_SB(1, 0), cB + kstep, voffB); PG8_STAGE(PG8_SA(1, 0), cA + kstep, voffA); PG8_STAGE(PG8_SB(1, 1), cB + hstep + kstep, voffB);
        PG8_WAIT_V(6); PG8_BAR;
    } else {
        PG8_STAGE(PG8_SB(0, 0), cB, voffB); PG8_STAGE(PG8_SA(0, 0), cA, voffA); PG8_STAGE(PG8_SB(0, 1), cB + hstep, voffB); PG8_STAGE(PG8_SA(0, 1), cA + hstep, voffA);
        if (wr == 1) PG8_BAR;
        PG8_WAIT_V(4); PG8_BAR;
        PG8_STAGE(PG8_SB(1, 0), cB + kstep, voffB); PG8_STAGE(PG8_SA(1, 0), cA + kstep, voffA); PG8_STAGE(PG8_SB(1, 1), cB + hstep + kstep, voffB);
        PG8_WAIT_V(6); PG8_BAR;
    }
    for (;;) {
        const bool has_next = S.next(ui + 1, nxt);
        const char* nA = has_next ? (const char*)g.A + (size_t)nxt.pm * tstep : cA; const char* nB = has_next ? (const char*)g.Bt + (size_t)nxt.pn * tstep : cB;
        for (int t = 0; t < nt; t += 2) {
            const bool last = (t == nt - 2);
            const char* a1 = cA + (size_t)(t + 1) * kstep;
            const char* a2 = last ? nA : cA + (size_t)(t + 2) * kstep; const char* b2 = last ? nB : cB + (size_t)(t + 2) * kstep;
            const char* a3 = a2 + kstep; const char* b3 = b2 + kstep;
            if (last && has_next) S.a_ready(nxt);
            if constexpr (SP2) {
            PG8_LDB(B0, 0, 0); PG8_LDB(B1, 0, 1); PG8_SCHED; PG8_LDA(At, 0, 0); PG8_STAGE(PG8_SA(1, 1), a1 + hstep, voffA);
            PG8_WAIT_V(8); PG8_WAIT_L(0); PG8_BAR; PG8_MMA(0, 0, At, B0); PG8_MMA(0, 1, At, B1); PG8_BAR; PG8_SCHED;
            PG8_LDA(At, 0, 1); PG8_STAGE(PG8_SB(0, 0), b2, voffB); PG8_STAGE(PG8_SB(0, 1), b2 + hstep, voffB); PG8_STAGE(PG8_SA(0, 0), a2, voffA);
            PG8_WAIT_V(8); PG8_WAIT_L(0); PG8_BAR; PG8_MMA(1, 0, At, B0); PG8_MMA(1, 1, At, B1); PG8_BAR; PG8_SCHED;
            PG8_LDB(B0, 1, 0); PG8_LDB(B1, 1, 1); PG8_SCHED; PG8_LDA(At, 1, 0); PG8_STAGE(PG8_SA(0, 1), a2 + hstep, voffA);
            PG8_WAIT_V(8); PG8_WAIT_L(0); PG8_BAR; PG8_MMA(0, 0, At, B0); PG8_MMA(0, 1, At, B1); PG8_BAR; PG8_SCHED;
            PG8_LDA(At, 1, 1); PG8_STAGE(PG8_SB(1, 0), b3, voffB); PG8_STAGE(PG8_SB(1, 1), b3 + hstep, voffB); PG8_STAGE(PG8_SA(1, 0), a3, voffA);
            PG8_WAIT_V(8); PG8_WAIT_L(0); PG8_BAR; PG8_MMA(1, 0, At, B0); PG8_MMA(1, 1, At, B1); PG8_BAR; PG8_SCHED;
            } else {
            PG8_LDB(B0, 0, 0); PG8_SCHED; PG8_LDA(At, 0, 0); PG8_STAGE(PG8_SA(1, 1), a1 + hstep, voffA);
            PG8_WAIT_L(8); PG8_BAR; PG8_WAIT_L(0); PG8_MMA(0, 0, At, B0); PG8_BAR; PG8_SCHED;
            PG8_LDB(B1, 0, 1); PG8_STAGE(PG8_SB(0, 0), b2, voffB);
            PG8_BAR; PG8_WAIT_L(0); PG8_MMA(0, 1, At, B1); PG8_BAR;
            PG8_LDA(At, 0, 1); PG8_STAGE(PG8_SA(0, 0), a2, voffA);
            PG8_BAR; PG8_WAIT_L(0); PG8_MMA(1, 0, At, B0); PG8_BAR; PG8_SCHED;
            PG8_STAGE(PG8_SB(0, 1), b2 + hstep, voffB);
            PG8_WAIT_V(6); PG8_BAR; PG8_MMA(1, 1, At, B1); PG8_BAR;
            PG8_LDB(B0, 1, 0); PG8_SCHED; PG8_LDA(At, 1, 0); PG8_STAGE(PG8_SA(0, 1), a2 + hstep, voffA);
            PG8_WAIT_L(8); PG8_BAR; PG8_WAIT_L(0); PG8_MMA(0, 0, At, B0); PG8_BAR; PG8_SCHED;
            PG8_LDB(B1, 1, 1); PG8_STAGE(PG8_SB(1, 0), b3, voffB);
            PG8_BAR; PG8_WAIT_L(0); PG8_MMA(0, 1, At, B1); PG8_BAR;
            PG8_LDA(At, 1, 1); PG8_STAGE(PG8_SA(1, 0), a3, voffA);
            PG8_BAR; PG8_WAIT_L(0); PG8_MMA(1, 0, At, B0); PG8_BAR; PG8_SCHED;
            PG8_STAGE(PG8_SB(1, 1), b3 + hstep, voffB);
            PG8_WAIT_V(6); PG8_BAR; PG8_MMA(1, 1, At, B1); PG8_BAR;
            }
        }
        if constexpr (ALIGN_EPI) { if (wr == 0) PG8_BAR; }
        if constexpr (!Epi::AFTER_DRAIN) { E(acc, cur, wr, wc, fr, fq); S.done(cur); }
        if (!has_next) break;
#pragma unroll
        for (int a = 0; a < 2; ++a)
#pragma unroll
            for (int b = 0; b < 2; ++b)
#pragma unroll
                for (int m = 0; m < 4; ++m)
#pragma unroll
                    for (int n = 0; n < 2; ++n) acc[a][b][m][n] = (f32x4){0.f, 0.f, 0.f, 0.f};
        cur = nxt; cA = nA; cB = nB; ++ui;
        if constexpr (ALIGN_EPI) { if (wr == 1) PG8_BAR; }
    }
    PG8_WAIT_V(0);
    if constexpr (!ALIGN_EPI) { if (wr == 0) PG8_BAR; }
    PG8_BAR;
    if constexpr (Epi::AFTER_DRAIN) { E.fused(acc, cur, wr, wc, fr, fq, lds, wid, lane); S.done(cur); }
#undef PG8_SA
#undef PG8_SB
#undef PG8_STAGE
#undef PG8_LDA
#undef PG8_LDB
#undef PG8_MMA
#undef PG8_WAIT_V
#undef PG8_WAIT_L
#undef PG8_BAR
#undef PG8_SCHED
}
}

constexpr int NWAVES = 8;
constexpr int BATCH = 4, SEQ = 8192, D = 1024, M = BATCH * SEQ, DIN = 5120, FF = 4096, PLE = 256, AW = 512, NH = 8, HD = 64;
constexpr float EPS = 1e-6f;
constexpr int C_Q = 0, C_K = 512, C_V = 1024, C_CB = 1536, C_CC = 2048, C_CU = 2560, C_GA = 3072, C_GC = 4096;
constexpr size_t MiB = 1u << 20;
constexpr size_t WS_WIN = 1 * MiB, WS_WA = 11 * MiB, WS_WC = 12 * MiB, WS_WO = 13 * MiB, WS_WUP = 15 * MiB, WS_WDN = 23 * MiB, WS_WPG = 31 * MiB, WS_WPP = 33 * MiB;
constexpr size_t WS_R1 = 34 * MiB;
constexpr size_t WS_R2 = 98 * MiB;
constexpr size_t WS_R3 = 162 * MiB;
constexpr size_t WS_PB = 482 * MiB;
constexpr size_t WS_XB = 500 * MiB;
constexpr size_t WS_END = 504 * MiB;
constexpr size_t WS_CNT = 65536;
constexpr int RING_BYTES = 131072, LDS_BYTES = 147456;

#define GAS __attribute__((address_space(1)))
#define LAS __attribute__((address_space(3)))
typedef unsigned short bf16;
typedef unsigned v4u __attribute__((ext_vector_type(4)));
typedef unsigned v2u __attribute__((ext_vector_type(2)));
typedef float f32x4 __attribute__((ext_vector_type(4)));
typedef float f32x16 __attribute__((ext_vector_type(16)));
typedef short bf16x8 __attribute__((ext_vector_type(8)));
using pg8::pk_bf16; using pg8::bf_lo; using pg8::bf_hi;
#define LDS_WAIT() asm volatile("s_waitcnt lgkmcnt(0)" ::: "memory")

#define XB_TMO      128
#define XB_XCNT(j)  (256  + 64 * (j))
#define XB_XSUB(j)  (1280 + 64 * (j))
#define XB_XGEN(j)  (2304 + 64 * (j))
#define XB_TOP      3328
#define XB_TOPGEN   3392
#define XCD_BAR_WORDS 3456
#define XB_SPIN_CAP (1u << 18)

__device__ __forceinline__ unsigned xb_ld(unsigned* p)              { return __hip_atomic_load(p, __ATOMIC_RELAXED, __HIP_MEMORY_SCOPE_AGENT); }
__device__ __forceinline__ unsigned xb_add(unsigned* p, unsigned v) { return __hip_atomic_fetch_add(p, v, __ATOMIC_RELAXED, __HIP_MEMORY_SCOPE_AGENT); }
__device__ __forceinline__ unsigned xb_xcc_id() { return (unsigned)__builtin_amdgcn_s_getreg((3 << 11) | 20) & 0xFu; }
#define XB_SPIN(cond, bar) do { unsigned _sp = 0; while (cond) { __builtin_amdgcn_s_sleep(1); \
    if ((++_sp & 255u) == 0u) { if (xb_ld(&(bar)[XB_TMO])) break; if (_sp > XB_SPIN_CAP) { atomicAdd(&(bar)[XB_TMO], 1u); break; } } } } while (0)

struct XcdBarrier {
    unsigned* bar; unsigned x;
    volatile LAS unsigned* st;
};

__device__ __forceinline__ XcdBarrier xcd_barrier_post(unsigned* bar, volatile LAS unsigned* st) {
    XcdBarrier b; b.bar = bar; b.x = xb_xcc_id(); b.st = st;
    if (threadIdx.x == 0) (void)xb_add(&bar[XB_XCNT(b.x)], 1u);
    return b;
}
__device__ __forceinline__ void xcd_barrier_complete(unsigned* bar, unsigned x, unsigned& nloc, unsigned& nx) {
    const unsigned G = gridDim.x * gridDim.y * gridDim.z;
    unsigned sum, cnt, mine, sp = 0u;
    for (;;) {
        sum = 0u; cnt = 0u; mine = 0u;
#pragma unroll
        for (unsigned j = 0; j < 16; ++j) { const unsigned c = xb_ld(&bar[XB_XCNT(j)]); sum += c; cnt += (c > 0u) ? 1u : 0u; mine = (j == x) ? c : mine; }
        if (sum == G) break;
        __builtin_amdgcn_s_sleep(1);
        if ((++sp & 255u) == 0u) { if (xb_ld(&bar[XB_TMO])) break; if (sp > XB_SPIN_CAP) { atomicAdd(&bar[XB_TMO], 1u); break; } }
    }
    nloc = mine > 0u ? mine : 1u; nx = cnt > 0u ? cnt : 1u;
}

__device__ __forceinline__ void xcd_barrier(const XcdBarrier& b) {
    asm volatile("s_waitcnt vmcnt(0)" ::: "memory");
    __syncthreads();
    if (threadIdx.x == 0) {
        unsigned* bar = b.bar;
        __builtin_amdgcn_s_waitcnt(0);
        unsigned nloc = b.st[0], nx = b.st[1];
        if (nloc == 0u) { xcd_barrier_complete(bar, b.x, nloc, nx); b.st[0] = nloc; b.st[1] = nx; }
        const unsigned old = xb_add(&bar[XB_XSUB(b.x)], 1u);
        const unsigned gen = old / nloc;
        if (old + 1u == (gen + 1u) * nloc) {
            __builtin_amdgcn_fence(__ATOMIC_RELEASE, "agent");
            asm volatile("s_waitcnt vmcnt(0)" ::: "memory");
            const unsigned og = xb_add(&bar[XB_TOP], 1u);
            const unsigned tg = og / nx;
            if (og + 1u == (tg + 1u) * nx) xb_add(&bar[XB_TOPGEN], 1u);
            else XB_SPIN(xb_ld(&bar[XB_TOPGEN]) == tg, bar);
            __builtin_amdgcn_fence(__ATOMIC_ACQUIRE, "agent");
            xb_add(&bar[XB_XGEN(b.x)], 1u);
            asm volatile("s_waitcnt vmcnt(0)" ::: "memory");
        } else {
            XB_SPIN(xb_ld(&bar[XB_XGEN(b.x)]) == gen, bar);
            __builtin_amdgcn_fence(__ATOMIC_ACQUIRE, "agent");
            asm volatile("s_waitcnt vmcnt(0)" ::: "memory");
        }
    }
    __syncthreads();
}


__device__ __forceinline__ float wave_sum(float v) {
#pragma unroll
    for (int o = 1; o < 64; o <<= 1) v += __shfl_xor(v, o);
    return v;
}
__device__ __forceinline__ void p0_transpose_item(const float* W, int K, int N, bf16* WT, LAS float* scr, int item, int lane) {
    const int nblk = N / 32, kb = item / nblk, nb = item % nblk, k0 = 64 * kb, n0 = 32 * nb;
#pragma unroll 8
    for (int i = 0; i < 32; ++i) { const int kk = 2 * i + (lane >> 5); scr[kk * 33 + (lane & 31)] = W[(size_t)(k0 + kk) * N + n0 + (lane & 31)]; }
    LDS_WAIT(); asm volatile("" ::: "memory");
    const int c = lane & 7;
#pragma unroll
    for (int j = 0; j < 4; ++j) { const int n = (lane >> 3) + 8 * j; const LAS float* s = scr + (8 * c) * 33 + n;
        v4u o; o.x = pk_bf16(s[0 * 33], s[1 * 33]); o.y = pk_bf16(s[2 * 33], s[3 * 33]); o.z = pk_bf16(s[4 * 33], s[5 * 33]); o.w = pk_bf16(s[6 * 33], s[7 * 33]);
        *(v4u*)(WT + (size_t)(n0 + n) * K + k0 + 8 * c) = o; }
    LDS_WAIT(); asm volatile("" ::: "memory");
}
__device__ __forceinline__ void rms_row_to_bf16(const float* xrow, const float* g, bf16* orow, int lane) {
    const f32x4* xr = (const f32x4*)xrow + lane; const f32x4* gr = (const f32x4*)g + lane;
    f32x4 v[4]; float s = 0.f;
#pragma unroll
    for (int j = 0; j < 4; ++j) { v[j] = xr[64 * j]; s += (v[j].x * v[j].x + v[j].y * v[j].y) + (v[j].z * v[j].z + v[j].w * v[j].w); }
    const float rstd = 1.0f / sqrtf(wave_sum(s) * (1.f / D) + EPS);
    v2u* o8 = (v2u*)orow + lane;
#pragma unroll
    for (int j = 0; j < 4; ++j) { const f32x4 gg = gr[64 * j]; v2u w; w.x = pk_bf16(v[j].x * rstd * gg.x, v[j].y * rstd * gg.y); w.y = pk_bf16(v[j].z * rstd * gg.z, v[j].w * rstd * gg.w); o8[64 * j] = w; }
}
__device__ __forceinline__ void res_norm_row(const bf16* yrow, const float* base, float* out, const float* g1, const float* g2, bf16* xn, int lane) {
    const v2u* yr = (const v2u*)yrow + lane; const f32x4* br = (const f32x4*)base + lane; const f32x4* g1r = (const f32x4*)g1 + lane; const f32x4* g2r = (const f32x4*)g2 + lane;
    f32x4 y[4], x[4]; float s = 0.f;
#pragma unroll
    for (int j = 0; j < 4; ++j) { const v2u w = yr[64 * j]; y[j] = (f32x4){bf_lo(w.x), bf_hi(w.x), bf_lo(w.y), bf_hi(w.y)}; x[j] = br[64 * j];
        s += (y[j].x * y[j].x + y[j].y * y[j].y) + (y[j].z * y[j].z + y[j].w * y[j].w); }
    const float rstd = 1.0f / sqrtf(wave_sum(s) * (1.f / D) + EPS);
    float s2 = 0.f;
#pragma unroll
    for (int j = 0; j < 4; ++j) { const f32x4 gg = g1r[64 * j]; x[j] = x[j] + y[j] * rstd * gg; s2 += (x[j].x * x[j].x + x[j].y * x[j].y) + (x[j].z * x[j].z + x[j].w * x[j].w); }
    f32x4* orow = (f32x4*)out + lane;
#pragma unroll
    for (int j = 0; j < 4; ++j) orow[64 * j] = x[j];
    const float rstd2 = 1.0f / sqrtf(wave_sum(s2) * (1.f / D) + EPS);
    v2u* o8 = (v2u*)xn + lane;
#pragma unroll
    for (int j = 0; j < 4; ++j) { const f32x4 gg = g2r[64 * j]; v2u w; w.x = pk_bf16(x[j].x * rstd2 * gg.x, x[j].y * rstd2 * gg.y); w.y = pk_bf16(x[j].z * rstd2 * gg.z, x[j].w * rstd2 * gg.w); o8[64 * j] = w; }
}

#define MFMA32(a, b, c) __builtin_amdgcn_mfma_f32_32x32x16_bf16((a), (b), (c), 0, 0, 0)
__device__ __forceinline__ void attn_unit(const bf16* __restrict__ PROJ, bf16* __restrict__ O, int b, int h, int qt, int lane) {
    const int r = lane & 31, hh = lane >> 5;
    const size_t rowbase = (size_t)b * SEQ;
    const int t0 = qt * 32;
    const bf16* qp = PROJ + (rowbase + t0 + r) * DIN + C_Q + h * HD + 8 * hh;
    bf16x8 qf[4];
#pragma unroll
    for (int ds = 0; ds < 4; ++ds) qf[ds] = *(const bf16x8*)(qp + 16 * ds);
    f32x16 o0, o1;
#pragma unroll
    for (int i = 0; i < 16; ++i) { o0[i] = 0.f; o1[i] = 0.f; }
    float A = 0.f;
    const float L2E = 1.4426950408889634f, LN2 = 0.6931471805599453f;
    for (int kb = qt; kb >= 0; --kb) {
        const int k0 = kb * 32;
        const bf16* kp = PROJ + (rowbase + k0 + r) * DIN + C_K + h * HD + 8 * hh;
        bf16x8 kf[4];
#pragma unroll
        for (int ds = 0; ds < 4; ++ds) kf[ds] = *(const bf16x8*)(kp + 16 * ds);
        const bf16* vp = PROJ + (rowbase + k0 + 4 * hh) * DIN + C_V + h * HD + r;
        bf16x8 va[2][2];
#pragma unroll
        for (int s = 0; s < 2; ++s)
#pragma unroll
            for (int dh = 0; dh < 2; ++dh)
#pragma unroll
                for (int j = 0; j < 8; ++j) va[s][dh][j] = (short)vp[(size_t)(16 * s + 8 * (j >> 2) + (j & 3)) * DIN + 32 * dh];
        f32x16 st;
#pragma unroll
        for (int i = 0; i < 16; ++i) st[i] = 0.f;
#pragma unroll
        for (int ds = 0; ds < 4; ++ds) st = MFMA32(kf[ds], qf[ds], st);
        const bool diag = (kb == qt);
        float lk[16], lb[16];
#pragma unroll
        for (int i = 0; i < 16; ++i) {
            const float z = st[i] * 0.125f;
            const float e = __builtin_amdgcn_exp2f(-fabsf(z) * L2E);
            const float l = __builtin_amdgcn_logf(1.0f + e) * LN2;
            lb[i] = fminf(z, 0.f) - l;
            lk[i] = -fmaxf(z, 0.f) - l;
            if (diag) { const int kk = (i & 3) + 8 * (i >> 2) + 4 * hh; if (!(kk < r)) { lk[i] = 0.f; lb[i] = -INFINITY; } }
        }
        float within[16], c[4], cp[4];
#pragma unroll
        for (int g = 0; g < 4; ++g) { const float s3 = lk[4 * g + 3], s2 = s3 + lk[4 * g + 2], s1 = s2 + lk[4 * g + 1]; c[g] = s1 + lk[4 * g];
            within[4 * g + 3] = 0.f; within[4 * g + 2] = s3; within[4 * g + 1] = s2; within[4 * g] = s1; }
#pragma unroll
        for (int g = 0; g < 4; ++g) cp[g] = __shfl_xor(c[g], 32);
        const float T0 = c[0] + cp[0], T1 = c[1] + cp[1], T2 = c[2] + cp[2], T3 = c[3] + cp[3];
        float suf[4]; suf[3] = 0.f; suf[2] = T3; suf[1] = T3 + T2; suf[0] = suf[1] + T1;
        const float total = suf[0] + T0;
        float w[16];
#pragma unroll
        for (int g = 0; g < 4; ++g) { const float base = A + suf[g] + (hh == 0 ? cp[g] : 0.f);
#pragma unroll
            for (int i = 0; i < 4; ++i) w[4 * g + i] = __builtin_amdgcn_exp2f((lb[4 * g + i] + (base + within[4 * g + i])) * L2E); }
        v4u p0, p1;
        p0.x = pk_bf16(w[0], w[1]); p0.y = pk_bf16(w[2], w[3]); p0.z = pk_bf16(w[4], w[5]); p0.w = pk_bf16(w[6], w[7]);
        p1.x = pk_bf16(w[8], w[9]); p1.y = pk_bf16(w[10], w[11]); p1.z = pk_bf16(w[12], w[13]); p1.w = pk_bf16(w[14], w[15]);
        const bf16x8 x0 = __builtin_bit_cast(bf16x8, p0), x1 = __builtin_bit_cast(bf16x8, p1);
        o0 = MFMA32(va[0][0], x0, o0); o0 = MFMA32(va[1][0], x1, o0);
        o1 = MFMA32(va[0][1], x0, o1); o1 = MFMA32(va[1][1], x1, o1);
        A += total;
        if (__builtin_amdgcn_ballot_w64(A > -88.0f) == 0ull) break;
    }
    bf16* op = O + (rowbase + t0 + r) * AW + h * HD + 4 * hh;
#pragma unroll
    for (int g = 0; g < 4; ++g) {
        v2u a; a.x = pk_bf16(o0[4 * g], o0[4 * g + 1]); a.y = pk_bf16(o0[4 * g + 2], o0[4 * g + 3]); *(v2u*)(op + 8 * g) = a;
        v2u c2; c2.x = pk_bf16(o1[4 * g], o1[4 * g + 1]); c2.y = pk_bf16(o1[4 * g + 2], o1[4 * g + 3]); *(v2u*)(op + 32 + 8 * g) = c2;
    }
}
__device__ __forceinline__ void conv_item(const bf16* __restrict__ PROJ, const float* __restrict__ wconv, bf16* __restrict__ CM, int it) {
    const int cgp = it & 63, run = it >> 6, c0 = cgp * 8; const int t_start = run * 16; const bool first = (t_start % SEQ) == 0;
    f32x4 w0a = *(const f32x4*)(wconv + c0), w0b = *(const f32x4*)(wconv + c0 + 4), w1a = *(const f32x4*)(wconv + AW + c0), w1b = *(const f32x4*)(wconv + AW + c0 + 4),
          w2a = *(const f32x4*)(wconv + 2 * AW + c0), w2b = *(const f32x4*)(wconv + 2 * AW + c0 + 4);
    f32x4 m2a = {0.f, 0.f, 0.f, 0.f}, m2b = m2a, m1a = m2a, m1b = m2a;
    if (!first) {
        f32x4 a0, a1, b0, b1;
        pg8::unpack8(*(const v4u*)(PROJ + (size_t)(t_start - 2) * DIN + C_CC + c0), a0, a1); pg8::unpack8(*(const v4u*)(PROJ + (size_t)(t_start - 2) * DIN + C_CU + c0), b0, b1); m2a = a0 * b0; m2b = a1 * b1;
        pg8::unpack8(*(const v4u*)(PROJ + (size_t)(t_start - 1) * DIN + C_CC + c0), a0, a1); pg8::unpack8(*(const v4u*)(PROJ + (size_t)(t_start - 1) * DIN + C_CU + c0), b0, b1); m1a = a0 * b0; m1b = a1 * b1;
    }
#pragma unroll 4
    for (int t = 0; t < 16; ++t) {
        const bf16* rowp = PROJ + (size_t)(t_start + t) * DIN + c0;
        f32x4 a0, a1, b0, b1, g0, g1;
        pg8::unpack8(*(const v4u*)(rowp + C_CC), a0, a1); pg8::unpack8(*(const v4u*)(rowp + C_CU), b0, b1); pg8::unpack8(*(const v4u*)(rowp + C_CB), g0, g1);
        const f32x4 ma = a0 * b0, mb = a1 * b1;
        const f32x4 ra = g0 * (w0a * m2a + w1a * m1a + w2a * ma), rb = g1 * (w0b * m2b + w1b * m1b + w2b * mb);
        *(v4u*)(CM + (size_t)(t_start + t) * AW + c0) = pg8::pack8(ra, rb);
        m2a = m1a; m2b = m1b; m1a = ma; m1b = mb;
    }
}

struct Args { const float* in[17]; float* out; unsigned char* ws; int ph_lo, ph_hi; };
__global__ void __launch_bounds__(NWAVES * 64, 2) fwd_megakernel(Args args) {
    extern __shared__ __attribute__((aligned(16))) unsigned char lds_raw[];
    LAS unsigned char* lds = (LAS unsigned char*)lds_raw;
    cg::grid_group grid = cg::this_grid();
    const int tid = threadIdx.x, lane = tid & 63, wave = __builtin_amdgcn_readfirstlane(tid >> 6);
    const int G = gridDim.x, bx = blockIdx.x;
    const int gw = bx * NWAVES + wave, NGW = G * NWAVES;
    unsigned char* ws = args.ws;
    const float* x = args.in[0]; const float* p = args.in[1]; const float* g_pre_mix = args.in[2]; const float* w_in = args.in[3]; const float* b_gate = args.in[4];
    const float* w_conv = args.in[5]; const float* w_attn_out = args.in[6]; const float* w_conv_out = args.in[7]; const float* w_o = args.in[8]; const float* g_post_mix = args.in[9];
    const float* g_pre_mlp = args.in[10]; const float* w_up = args.in[11]; const float* w_down = args.in[12]; const float* g_post_mlp = args.in[13]; const float* g_ple = args.in[14];
    const float* w_ple_gate = args.in[15]; const float* w_ple_proj = args.in[16];
    float* out = args.out;
    bf16* Win_t = (bf16*)(ws + WS_WIN); bf16* Wa_t = (bf16*)(ws + WS_WA); bf16* Wc_t = (bf16*)(ws + WS_WC); bf16* Wo_t = (bf16*)(ws + WS_WO);
    bf16* Wup_t = (bf16*)(ws + WS_WUP); bf16* Wdn_t = (bf16*)(ws + WS_WDN); bf16* Wpg_t = (bf16*)(ws + WS_WPG); bf16* Wpp_t = (bf16*)(ws + WS_WPP);
    bf16* R1 = (bf16*)(ws + WS_R1); bf16* R2 = (bf16*)(ws + WS_R2); bf16* R3 = (bf16*)(ws + WS_R3); bf16* PB = (bf16*)(ws + WS_PB);
    bf16* XN = R1; bf16* MB = R1; bf16* Y6 = R1; bf16* GB = R1;
    bf16* OB = R2; bf16* CM = R2 + (size_t)M * AW; bf16* XN2 = R2; bf16* XN3 = R2;
    bf16* PROJ = R3; bf16* Y4 = R3; bf16* HB = R3;
    const int lo = args.ph_lo, hi = args.ph_hi;
    volatile LAS unsigned* bst = (volatile LAS unsigned*)(lds + RING_BYTES + 384);
    if (tid < 2) bst[tid] = 0u;
    __syncthreads();
    if (lo < 0) grid.sync();
    XcdBarrier bar; bar.bar = (unsigned*)ws; bar.x = 0; bar.st = bst;
    if (hi - lo > 1) bar = xcd_barrier_post((unsigned*)ws, bst);
#ifndef PROBE_DUP_MASK
#define PROBE_DUP_MASK 0
#endif
#ifndef PROBE_DUP_SYNC
#define PROBE_DUP_SYNC 0
#endif
#define IN(k) (lo <= (k) && (k) < hi)
#define REP(k) for (int rep_ = 0; rep_ < (((PROBE_DUP_MASK >> (k)) & 1) ? 2 : 1); ++rep_)
#define SEAM(k) do { if (IN(k) && IN((k) + 1)) { xcd_barrier(bar); if (PROBE_DUP_SYNC) xcd_barrier(bar); } } while (0)

    if (IN(0)) REP(0) {
        LAS float* scr = (LAS float*)(lds + wave * 16384);
        constexpr int I_IN = (D / 64) * (DIN / 32), I_A = (AW / 64) * (D / 32), I_O = (D / 64) * (D / 32), I_UP = (D / 64) * (FF / 32), I_DN = (FF / 64) * (D / 32), I_PP = (PLE / 64) * (D / 32);
        constexpr int NITEMS = I_IN + 2 * I_A + 2 * I_O + I_UP + I_DN + I_PP;
        for (int it = gw; it < NITEMS; it += NGW) {
            int r = it;
            if (r < I_IN) { p0_transpose_item(w_in, D, DIN, Win_t, scr, r, lane); continue; } r -= I_IN;
            if (r < I_A) { p0_transpose_item(w_attn_out, AW, D, Wa_t, scr, r, lane); continue; } r -= I_A;
            if (r < I_A) { p0_transpose_item(w_conv_out, AW, D, Wc_t, scr, r, lane); continue; } r -= I_A;
            if (r < I_O) { p0_transpose_item(w_o, D, D, Wo_t, scr, r, lane); continue; } r -= I_O;
            if (r < I_UP) { p0_transpose_item(w_up, D, FF, Wup_t, scr, r, lane); continue; } r -= I_UP;
            if (r < I_DN) { p0_transpose_item(w_down, FF, D, Wdn_t, scr, r, lane); continue; } r -= I_DN;
            if (r < I_O) { p0_transpose_item(w_ple_gate, D, D, Wpg_t, scr, r, lane); continue; } r -= I_O;
            p0_transpose_item(w_ple_proj, PLE, D, Wpp_t, scr, r, lane);
        }
        for (int m = gw; m < M; m += NGW) rms_row_to_bf16(x + (size_t)m * D, g_pre_mix, XN + (size_t)m * D, lane);
        for (int i = bx * (NWAVES * 64) + tid; i < M * PLE / 8; i += G * NWAVES * 64) {
            const f32x4 a = *(const f32x4*)(p + (size_t)i * 8), b2 = *(const f32x4*)(p + (size_t)i * 8 + 4);
            *(v4u*)(PB + (size_t)i * 8) = pg8::pack8(a, b2);
        }
        __syncthreads();
    }
    SEAM(0);
    if (IN(1)) REP(1) {
        pg8::Gemm g{XN, Win_t, M, DIN, D}; pg8::StaticOrder S; S.init(M, DIN, G, bx);
        pg8::EpiTile8<pg8::FProj> E{{PROJ, b_gate}};
        pg8::gemm_phase<pg8::EpiTile8<pg8::FProj>, pg8::StaticOrder, true, true>(lds, g, S, E);
    }
    SEAM(1);
    if (IN(2)) REP(2) {
        constexpr int NQT = SEQ / 32, NUNITS = BATCH * NH * NQT;
        for (int u = gw; u < NUNITS; u += NGW) { const int qt = u % NQT, bh = u / NQT; attn_unit(PROJ, OB, bh / NH, bh % NH, qt, lane); }
        for (int it = bx * (NWAVES * 64) + tid; it < (M / 16) * 64; it += G * NWAVES * 64) conv_item(PROJ, w_conv, CM, it);
        __syncthreads();
    }
    SEAM(2);
    if (IN(3)) REP(3) {
        { pg8::Gemm g{OB, Wa_t, M, D, AW}; pg8::StaticOrder S; S.init(M, D, G, bx);
          pg8::EpiTile8<pg8::FMixA> E{{MB, PROJ + C_GA}};
          pg8::gemm_phase<pg8::EpiTile8<pg8::FMixA>, pg8::StaticOrder, true, true>(lds, g, S, E); }
        { pg8::Gemm g{CM, Wc_t, M, D, AW}; pg8::StaticOrder S; S.init(M, D, G, bx);
          pg8::EpiTile8<pg8::FMixC> E{{MB, PROJ + C_GC}};
          pg8::gemm_phase<pg8::EpiTile8<pg8::FMixC>, pg8::StaticOrder, true, true>(lds, g, S, E); }
    }
    SEAM(3);
    if (IN(4)) REP(4) {
        pg8::Gemm g{MB, Wo_t, M, D, D}; pg8::StaticOrder S; S.init(M, D, G, bx);
        pg8::PanelRms s1{(unsigned*)(ws + WS_XB), (unsigned*)(ws + WS_CNT), EPS}, s2{(unsigned*)(ws + WS_XB + 512 * 1024), (unsigned*)(ws + WS_CNT + 32768), EPS};
        pg8::EpiRmsResRms E{x, out, XN2, g_post_mix, g_pre_mlp, s1, s2, lds + RING_BYTES + 1024};
        pg8::gemm_phase<pg8::EpiRmsResRms, pg8::StaticOrder, true, true>(lds, g, S, E);
    }
    SEAM(4);
    if (IN(6)) REP(6) {
        pg8::Gemm g{XN2, Wup_t, M, FF, D}; pg8::StaticOrder S; S.init(M, FF, G, bx);
        pg8::EpiTile8<pg8::FStore<1>> E{{HB, FF}};
        pg8::gemm_phase<pg8::EpiTile8<pg8::FStore<1>>, pg8::StaticOrder, true, true>(lds, g, S, E);
    }
    SEAM(6);
    if (IN(7)) REP(7) {
        pg8::Gemm g{HB, Wdn_t, M, D, FF}; pg8::StaticOrder S; S.init(M, D, G, bx);
        pg8::PanelRms s1{(unsigned*)(ws + WS_XB + 2 * 512 * 1024), (unsigned*)(ws + WS_CNT + 2 * 32768), EPS}, s2{(unsigned*)(ws + WS_XB + 3 * 512 * 1024), (unsigned*)(ws + WS_CNT + 3 * 32768), EPS};
        pg8::EpiRmsResRms E{out, out, XN3, g_post_mlp, g_ple, s1, s2, lds + RING_BYTES + 1024};
        pg8::gemm_phase<pg8::EpiRmsResRms, pg8::StaticOrder, true, true>(lds, g, S, E);
    }
    SEAM(7);
    if (IN(9)) REP(9) {
        { pg8::Gemm g{XN3, Wpg_t, M, D, D}; pg8::StaticOrder S; S.init(M, D, G, bx);
          pg8::EpiTile8<pg8::FStore<2>> E{{GB, D}};
          pg8::gemm_phase<pg8::EpiTile8<pg8::FStore<2>>, pg8::StaticOrder, true, true>(lds, g, S, E); }
        { pg8::Gemm g{PB, Wpp_t, M, D, PLE}; pg8::StaticOrder S; S.init(M, D, G, bx);
          pg8::EpiTile8<pg8::FFinal> E{{out, GB}};
          pg8::gemm_phase<pg8::EpiTile8<pg8::FFinal>, pg8::StaticOrder, true, true>(lds, g, S, E); }
    }
#undef IN
#undef SEAM
}

#ifndef MK_N_LAUNCHES
#define MK_N_LAUNCHES 1
#endif
constexpr int N_PHASES = 10;
extern "C" void kernel_launch(void* const* d_in, const int* in_sizes, int n_in, void* d_out, int out_size, void* d_ws, size_t ws_size, hipStream_t stream) {
    static int grid = 0;
    if (grid == 0) {
        if (n_in != 17 || in_sizes[0] != M * D || out_size != M * D || ws_size < WS_END) { fprintf(stderr, "kernel_launch: unexpected shapes (n_in %d, in0 %d, out %d, ws %zu)\n", n_in, n_in > 0 ? in_sizes[0] : -1, out_size, ws_size); grid = -1; return; }
        int dev = 0, cus = 0, per_cu = 0;
        hipGetDevice(&dev); hipDeviceGetAttribute(&cus, hipDeviceAttributeMultiprocessorCount, dev);
        if (hipFuncSetAttribute((const void*)fwd_megakernel, hipFuncAttributeMaxDynamicSharedMemorySize, LDS_BYTES) != hipSuccess) { fprintf(stderr, "kernel_launch: hipFuncSetAttribute failed\n"); grid = -1; return; }
        if (hipOccupancyMaxActiveBlocksPerMultiprocessor(&per_cu, (const void*)fwd_megakernel, NWAVES * 64, LDS_BYTES) != hipSuccess || per_cu < 1) { fprintf(stderr, "kernel_launch: occupancy query says %d\n", per_cu); per_cu = 1; }
        (void)hipGetLastError();
        grid = cus * per_cu;
        fprintf(stderr, "kernel_launch: grid %d (cus %d x %d)\n", grid, cus, per_cu);
    }
    if (grid < 0) return;
    Args a{};
    for (int i = 0; i < 17; ++i) a.in[i] = (const float*)d_in[i];
    a.out = (float*)d_out; a.ws = (unsigned char*)d_ws;
#if MK_N_LAUNCHES == 1
    a.ph_lo = 0; a.ph_hi = N_PHASES;
    if (hipMemsetAsync(d_ws, 0, 262144, stream) != hipSuccess) { fprintf(stderr, "kernel_launch: memset failed\n"); return; }
    void* kargs[] = {&a};
    hipError_t e = hipLaunchCooperativeKernel((const void*)fwd_megakernel, dim3(grid), dim3(NWAVES * 64), kargs, LDS_BYTES, stream);
    if (e != hipSuccess) fprintf(stderr, "cooperative launch failed: %s (grid %d)\n", hipGetErrorString(e), grid);
#else
    for (int ph = 0; ph < N_PHASES; ++ph) { a.ph_lo = ph; a.ph_hi = ph + 1; hipLaunchKernelGGL(fwd_megakernel, dim3(grid), dim3(NWAVES * 64), LDS_BYTES, stream, a); }
#endif
}
```

```cpp
#include <hip/hip_runtime.h>
#include <hip/hip_cooperative_groups.h>
#include <cstdio>
#include <cstdint>
namespace cg = cooperative_groups;
namespace pg8 {
#define PG8_LAS __attribute__((address_space(3)))
typedef unsigned short bf16_t;
typedef short bf16x8 __attribute__((ext_vector_type(8)));
typedef float f32x4 __attribute__((ext_vector_type(4)));
typedef unsigned u32x4 __attribute__((ext_vector_type(4)));
constexpr int BM = 256, BK = 64, HALF = 128, HTB = HALF * BK * 2  , STAGE_BYTES = 8 * HTB, NXCD = 8, WGM = 8;

__host__ __device__ __forceinline__ int lds_byte(int r, int c) { const int st = (r >> 4) * 2 + (c >> 5), rr = r & 15, cc = c & 31, ob = rr * 64 + cc * 2; return st * 1024 + (ob ^ (((ob >> 9) & 1) << 5)); }
__host__ __device__ __forceinline__ void stage_rc(int b, int& R, int& C) { const int st = b / 1024, sb = b % 1024, swz = sb ^ (((sb >> 9) & 1) << 5); R = (st >> 1) * 16 + swz / 64; C = (st & 1) * 32 + (swz % 64) / 2; }
__host__ __device__ __forceinline__ int perm32(int rho) { const int n = rho >> 4, i = rho & 15; return 8 * (i >> 2) + 4 * n + (i & 3); }

struct Unit { int pm, pn; };
struct Gemm { const bf16_t* A; const bf16_t* Bt; int M, N, K; };

struct StaticOrder {
    int nM, nN, nwg, G, c;
    __host__ __device__ void init(int M, int N, int G_, int c_) { nM = M / BM; nN = N / BM; nwg = nM * nN; G = G_; c = c_; }
    __host__ __device__ bool next(int i, Unit& u) const {
        const long L = (long)i * G + c; if (L >= nwg) return false;
        int wgid = (int)L; { const int q = nwg / NXCD, r = nwg % NXCD, xcd = wgid % NXCD, off = wgid / NXCD; wgid = (xcd < r ? xcd * (q + 1) : r * (q + 1) + (xcd - r) * q) + off; }
        const int nig = WGM * nN, gid = wgid / nig, fm = gid * WGM, gsz = (nM - fm) < WGM ? (nM - fm) : WGM;
        u.pm = fm + ((wgid % nig) % gsz); u.pn = (wgid % nig) / gsz; return true;
    }
    __device__ __forceinline__ void a_ready(const Unit&) const {}
    __device__ __forceinline__ void done(const Unit&) const {}
};

__device__ __forceinline__ unsigned cvt_pk_bf16(float lo, float hi) { unsigned r; asm volatile("v_cvt_pk_bf16_f32 %0, %1, %2" : "=v"(r) : "v"(lo), "v"(hi)); return r; }
typedef float f32x2 __attribute__((ext_vector_type(2)));
typedef __bf16 bf16x2_t __attribute__((ext_vector_type(2)));
__device__ __forceinline__ unsigned pk_bf16(float lo, float hi) { f32x2 v = {lo, hi}; bf16x2_t b = __builtin_convertvector(v, bf16x2_t); return __builtin_bit_cast(unsigned, b); }
__device__ __forceinline__ float bf_lo(unsigned w) { return __uint_as_float(w << 16); }
__device__ __forceinline__ float bf_hi(unsigned w) { return __uint_as_float(w & 0xffff0000u); }
__device__ __forceinline__ float sigmoidf_fast(float x) { return __builtin_amdgcn_rcpf(1.0f + __builtin_amdgcn_exp2f(-1.4426950408889634f * x)); }
__device__ __forceinline__ u32x4 pack8(const f32x4 a, const f32x4 b) { u32x4 w; w.x = pk_bf16(a[0], a[1]); w.y = pk_bf16(a[2], a[3]); w.z = pk_bf16(b[0], b[1]); w.w = pk_bf16(b[2], b[3]); return w; }
__device__ __forceinline__ void unpack8(const u32x4 w, f32x4& a, f32x4& b) { a = (f32x4){bf_lo(w.x), bf_hi(w.x), bf_lo(w.y), bf_hi(w.y)}; b = (f32x4){bf_lo(w.z), bf_hi(w.z), bf_lo(w.w), bf_hi(w.w)}; }

template <class F> struct EpiTile8 {
    static constexpr bool PERM = true, AFTER_DRAIN = false;
    F f;
    __device__ __forceinline__ void operator()(const f32x4 (&acc)[2][2][4][2], const Unit& u, int wr, int wc, int fr, int fq) const {
        const int row0 = u.pm * BM + wr * 64 + fr, col0 = u.pn * BM + wc * 32 + 8 * fq;
#pragma unroll
        for (int ai = 0; ai < 2; ++ai)
#pragma unroll
            for (int m = 0; m < 4; ++m) {
                const int row = row0 + ai * HALF + m * 16;
                float rs = 1.f; if constexpr (F::ROWSCALE) rs = f.rowscale(row);
#pragma unroll
                for (int bj = 0; bj < 2; ++bj) f(row, col0 + bj * HALF, u.pn, acc[ai][bj][m][0], acc[ai][bj][m][1], rs);
                if (F::FENCE && (m & 1)) asm volatile("" ::: "memory");
            }
    }
};
__device__ __forceinline__ float rstd16(const float* ssp, int row, float eps) {
    const f32x4* q = (const f32x4*)(ssp + (size_t)row * 16); const f32x4 a = q[0], b = q[1], c = q[2], d = q[3];
    const float t = (((a[0] + a[1]) + (a[2] + a[3])) + ((b[0] + b[1]) + (b[2] + b[3]))) + (((c[0] + c[1]) + (c[2] + c[3])) + ((d[0] + d[1]) + (d[2] + d[3])));
    return 1.0f / sqrtf(t * (1.0f / 1024.0f) + eps);
}
struct FProj { static constexpr bool FENCE = false, ROWSCALE = false; bf16_t* O; const float* bgate;
    __device__ __forceinline__ void operator()(int row, int col, int pn, f32x4 v0, f32x4 v1, float) const {
        if (pn >= 12) { const f32x4 b0 = *(const f32x4*)(bgate + col - 3072), b1 = *(const f32x4*)(bgate + col - 3072 + 4);
#pragma unroll
            for (int i = 0; i < 4; ++i) { v0[i] = sigmoidf_fast(v0[i] + b0[i]); v1[i] = sigmoidf_fast(v1[i] + b1[i]); } }
        *(u32x4*)(O + (size_t)row * 5120 + col) = pack8(v0, v1); } };
struct FMixA { static constexpr bool FENCE = false, ROWSCALE = false; bf16_t* MB; const bf16_t* G;
    __device__ __forceinline__ void operator()(int row, int col, int, f32x4 v0, f32x4 v1, float) const {
        f32x4 g0, g1; unpack8(*(const u32x4*)(G + (size_t)row * 5120 + col), g0, g1);
        *(u32x4*)(MB + (size_t)row * 1024 + col) = pack8(v0 * g0, v1 * g1); } };
struct FMixC { static constexpr bool FENCE = true, ROWSCALE = false; bf16_t* MB; const bf16_t* G;
    __device__ __forceinline__ void operator()(int row, int col, int, f32x4 v0, f32x4 v1, float) const {
        f32x4 g0, g1, m0, m1; unpack8(*(const u32x4*)(G + (size_t)row * 5120 + col), g0, g1); unpack8(*(const u32x4*)(MB + (size_t)row * 1024 + col), m0, m1);
        *(u32x4*)(MB + (size_t)row * 1024 + col) = pack8(m0 + v0 * g0, m1 + v1 * g1); } };
template <int ACT  > struct FStore { static constexpr bool FENCE = false, ROWSCALE = false; bf16_t* O; int ldc;
    __device__ __forceinline__ void operator()(int row, int col, int, f32x4 v0, f32x4 v1, float) const {
        if (ACT == 1) {
#pragma unroll
            for (int i = 0; i < 4; ++i) { const float a = fmaxf(v0[i], 0.f), b = fmaxf(v1[i], 0.f); v0[i] = a * a; v1[i] = b * b; } }
        if (ACT == 2) {
#pragma unroll
            for (int i = 0; i < 4; ++i) { v0[i] = sigmoidf_fast(v0[i]); v1[i] = sigmoidf_fast(v1[i]); } }
        *(u32x4*)(O + (size_t)row * ldc + col) = pack8(v0, v1); } };
struct FStoreRt { static constexpr bool FENCE = false, ROWSCALE = true; bf16_t* O; int ldc; int act; const float* ssp; float eps;
    __device__ __forceinline__ float rowscale(int row) const { return act == 1 ? rstd16(ssp, row, eps) : 1.f; }
    __device__ __forceinline__ void operator()(int row, int col, int, f32x4 v0, f32x4 v1, float rs) const {
        if (act == 1) {
#pragma unroll
            for (int i = 0; i < 4; ++i) { const float a = fmaxf(v0[i] * rs, 0.f), b = fmaxf(v1[i] * rs, 0.f); v0[i] = a * a; v1[i] = b * b; } }
        *(u32x4*)(O + (size_t)row * ldc + col) = pack8(v0, v1); } };
struct FFinal { static constexpr bool FENCE = true, ROWSCALE = true; const bf16_t* X2; float* out; const bf16_t* PP; const float* ssp; float eps;
    __device__ __forceinline__ float rowscale(int row) const { return rstd16(ssp, row, eps); }
    __device__ __forceinline__ void operator()(int row, int col, int, f32x4 v0, f32x4 v1, float rs) const {
        f32x4 g0, g1, x0, x1; unpack8(*(const u32x4*)(PP + (size_t)row * 1024 + col), g0, g1); unpack8(*(const u32x4*)(X2 + (size_t)row * 1024 + col), x0, x1);
        float* p = out + (size_t)row * 1024 + col;
#pragma unroll
        for (int i = 0; i < 4; ++i) { v0[i] = sigmoidf_fast(v0[i] * rs); v1[i] = sigmoidf_fast(v1[i] * rs); }
        *(f32x4*)p = x0 + g0 * v0; *(f32x4*)(p + 4) = x1 + g1 * v1; } };

struct PanelRms {
    unsigned* xbuf;
    unsigned* cnt;
    float eps;
    __device__ __forceinline__ void run(const f32x4 (&v)[2][2][4][2], const Unit& u, int wr, int wc, int fr, int fq, PG8_LAS unsigned char* tb, int wid, int lane) const {
        PG8_LAS float* P = (PG8_LAS float*)tb;
        PG8_LAS float* S = (PG8_LAS float*)(tb + 4096);
#pragma unroll
        for (int ai = 0; ai < 2; ++ai)
#pragma unroll
            for (int m = 0; m < 4; ++m) {
                float s = 0.f;
#pragma unroll
                for (int bj = 0; bj < 2; ++bj)
#pragma unroll
                    for (int n = 0; n < 2; ++n) { const f32x4 x = v[ai][bj][m][n]; s += (x[0] * x[0] + x[1] * x[1]) + (x[2] * x[2] + x[3] * x[3]); }
                s += __shfl_xor(s, 16); s += __shfl_xor(s, 32);
                if (fq == 0) P[(ai * HALF + wr * 64 + m * 16 + fr) * 4 + wc] = s;
            }
        asm volatile("s_waitcnt lgkmcnt(0)" ::: "memory"); __builtin_amdgcn_s_barrier(); asm volatile("" ::: "memory");
        const int row = wid * 32 + (lane & 31);
        if (lane < 32) {
            const f32x4 a = *(const PG8_LAS f32x4*)(P + row * 4);
            __hip_atomic_store(xbuf + ((size_t)(u.pm * BM + row) * 4 + u.pn), __float_as_uint((a[0] + a[1]) + (a[2] + a[3])), __ATOMIC_RELAXED, __HIP_MEMORY_SCOPE_AGENT);
        }
        asm volatile("s_waitcnt vmcnt(0)" ::: "memory");
        if (lane == 0) __hip_atomic_fetch_add(cnt + 64 * u.pm, 1u, __ATOMIC_RELAXED, __HIP_MEMORY_SCOPE_AGENT);
        if (wid == 0) {
            unsigned sp = 0;
            while ((unsigned)__builtin_amdgcn_readfirstlane(__hip_atomic_load(cnt + 64 * u.pm, __ATOMIC_RELAXED, __HIP_MEMORY_SCOPE_AGENT)) < 32u) { __builtin_amdgcn_s_sleep(2); if (++sp > (1u << 22)) break; }
            __builtin_amdgcn_fence(__ATOMIC_ACQUIRE, "agent");
        }
        asm volatile("s_waitcnt vmcnt(0) lgkmcnt(0)" ::: "memory"); __builtin_amdgcn_s_barrier(); asm volatile("" ::: "memory");
        if (lane < 32) {
            const unsigned* slot = xbuf + (size_t)(u.pm * BM + row) * 4; float t = 0.f;
#pragma unroll
            for (int k = 0; k < 4; ++k) t += __uint_as_float(__hip_atomic_load(slot + k, __ATOMIC_RELAXED, __HIP_MEMORY_SCOPE_AGENT));
            S[row] = 1.0f / sqrtf(t * (1.0f / 1024.0f) + eps);
        }
        asm volatile("s_waitcnt lgkmcnt(0)" ::: "memory"); __builtin_amdgcn_s_barrier(); asm volatile("" ::: "memory");
    }
};
template <bool BASE_BF16> struct EpiRmsRes {
    static constexpr bool PERM = true, AFTER_DRAIN = false;
    const void* base; bf16_t* xb; const float* g1; float* ssp; PanelRms st; PG8_LAS unsigned char* tb;
    __device__ __forceinline__ void operator()(f32x4 (&acc)[2][2][4][2], const Unit& u, int wr, int wc, int fr, int fq) const {
        const int wid = wr * 4 + wc, lane = fq * 16 + fr;
        const PG8_LAS float* S = (const PG8_LAS float*)(tb + 4096);
        const int col0 = u.pn * BM + wc * 32 + 8 * fq;
        st.run(acc, u, wr, wc, fr, fq, tb, wid, lane);
        f32x4 gv[2][2];
#pragma unroll
        for (int bj = 0; bj < 2; ++bj) { gv[bj][0] = *(const f32x4*)(g1 + col0 + bj * HALF); gv[bj][1] = *(const f32x4*)(g1 + col0 + bj * HALF + 4); }
#pragma unroll
        for (int ai = 0; ai < 2; ++ai)
#pragma unroll
            for (int m = 0; m < 4; ++m) { const int r = ai * HALF + wr * 64 + m * 16 + fr; const float rs = S[r]; const size_t off = (size_t)(u.pm * BM + r) * 1024 + col0; float s = 0.f;
#pragma unroll
                for (int bj = 0; bj < 2; ++bj) { f32x4 b0, b1;
                    if (BASE_BF16) unpack8(*(const u32x4*)((const bf16_t*)base + off + bj * HALF), b0, b1);
                    else { b0 = *(const f32x4*)((const float*)base + off + bj * HALF); b1 = *(const f32x4*)((const float*)base + off + bj * HALF + 4); }
                    const f32x4 a = b0 + acc[ai][bj][m][0] * rs * gv[bj][0], b = b1 + acc[ai][bj][m][1] * rs * gv[bj][1];
                    s += ((a[0] * a[0] + a[1] * a[1]) + (a[2] * a[2] + a[3] * a[3])) + ((b[0] * b[0] + b[1] * b[1]) + (b[2] * b[2] + b[3] * b[3]));
                    *(u32x4*)(xb + off + bj * HALF) = pack8(a, b); }
                s += __shfl_xor(s, 16); s += __shfl_xor(s, 32);
                if (fq == 0) ssp[(size_t)(u.pm * BM + r) * 16 + u.pn * 4 + wc] = s;
                if (m & 1) asm volatile("" ::: "memory"); }
    }
};

template <class Epi, class Sched, bool ALIGN_EPI = false, bool SP2 = false>
__device__ __forceinline__ void gemm_phase(PG8_LAS unsigned char* lds, const Gemm g, const Sched& S, const Epi& E) {
    int tid_ = threadIdx.x; asm volatile("" : "+v"(tid_));
    const int tid = tid_, wid = __builtin_amdgcn_readfirstlane(tid >> 6), lane = tid & 63, wr = wid >> 2, wc = wid & 3, fr = lane & 15, fq = lane >> 4;
    const int K = g.K, nt = K / BK;
    unsigned voffA[2], voffB[2];
#pragma unroll
    for (int i = 0; i < 2; ++i) { int R, C; stage_rc(tid * 16 + i * 8192, R, C); const int Rb = Epi::PERM ? ((R & ~31) + perm32(R & 31)) : R;
        voffA[i] = (unsigned)(R * K + C) * 2u; voffB[i] = (unsigned)(Rb * K + C) * 2u; }
    const size_t kstep = (size_t)(BK * 2);
    const size_t hstep = (size_t)HALF * K * 2;
    const size_t tstep = 2 * hstep;
    const unsigned ldsw = (unsigned)wid * 1024u;
    const int aoff = lds_byte(wr * 64 + fr, fq * 8), boff = lds_byte(wc * 32 + fr, fq * 8);
#define PG8_SA(b, h) (((b) * 2 + (h)) * HTB)
#define PG8_SB(b, h) ((4 + (b) * 2 + (h)) * HTB)
#define PG8_STAGE(bufoff, gbase, voff) do { _Pragma("unroll") for (int _i = 0; _i < 2; ++_i) \
        __builtin_amdgcn_global_load_lds((const unsigned*)((const char*)(gbase) + (voff)[_i]), (PG8_LAS unsigned*)(lds + (bufoff) + ldsw + _i * 8192), 16, 0, 0); } while (0)
#define PG8_LDA(dst, b, h) do { _Pragma("unroll") for (int m = 0; m < 4; ++m) _Pragma("unroll") for (int k = 0; k < 2; ++k) dst[m][k] = *(const PG8_LAS bf16x8*)(lds + PG8_SA(b, h) + aoff + m * 2048 + k * 1024); } while (0)
#define PG8_LDB(dst, b, h) do { _Pragma("unroll") for (int n = 0; n < 2; ++n) _Pragma("unroll") for (int k = 0; k < 2; ++k) dst[n][k] = *(const PG8_LAS bf16x8*)(lds + PG8_SB(b, h) + boff + n * 2048 + k * 1024); } while (0)
#define PG8_MMA(ai, bj, At, Bt) do { __builtin_amdgcn_s_setprio(1); _Pragma("unroll") for (int m = 0; m < 4; ++m) _Pragma("unroll") for (int n = 0; n < 2; ++n) _Pragma("unroll") for (int k = 0; k < 2; ++k) \
        acc[ai][bj][m][n] = __builtin_amdgcn_mfma_f32_16x16x32_bf16(Bt[n][k], At[m][k], acc[ai][bj][m][n], 0, 0, 0); __builtin_amdgcn_s_setprio(0); } while (0)
#define PG8_WAIT_V(n) asm volatile("s_waitcnt vmcnt(" #n ")" ::: "memory")
#define PG8_WAIT_L(n) asm volatile("s_waitcnt lgkmcnt(" #n ")" ::: "memory")
#define PG8_BAR __builtin_amdgcn_s_barrier()
#define PG8_SCHED __builtin_amdgcn_sched_barrier(0)
    Unit cur, nxt; int ui = 0;
    if (!S.next(0, cur)) return;
    f32x4 acc[2][2][4][2];
#pragma unroll
    for (int a = 0; a < 2; ++a)
#pragma unroll
        for (int b = 0; b < 2; ++b)
#pragma unroll
            for (int m = 0; m < 4; ++m)
#pragma unroll
                for (int n = 0; n < 2; ++n) acc[a][b][m][n] = (f32x4){0.f, 0.f, 0.f, 0.f};
    bf16x8 At[4][2], B0[2][2], B1[2][2];
    const char* cA = (const char*)g.A + (size_t)cur.pm * tstep; const char* cB = (const char*)g.Bt + (size_t)cur.pn * tstep;
    S.a_ready(cur);
    if constexpr (SP2) {
        PG8_STAGE(PG8_SB(0, 0), cB, voffB); PG8_STAGE(PG8_SB(0, 1), cB + hstep, voffB); PG8_STAGE(PG8_SA(0, 0), cA, voffA); PG8_STAGE(PG8_SA(0, 1), cA + hstep, voffA);
        if (wr == 1) PG8_BAR;
        PG8_WAIT_V(2); PG8_BAR;
        PG8_STAGE(PG8_SB(1, 0), cB + kstep, voffB); PG8_STAGE(PG8_SA(1, 0), cA + kstep, voffA); PG8_STAGE(PG8_SB(1, 1), cB + hstep + kstep, voffB);
        PG8_WAIT_V(6); PG8_BAR;
    } else {
        PG8_STAGE(PG8_SB(0, 0), cB, voffB); PG8_STAGE(PG8_SA(0, 0), cA, voffA); PG8_STAGE(PG8_SB(0, 1), cB + hstep, voffB); PG8_STAGE(PG8_SA(0, 1), cA + hstep, voffA);
        if (wr == 1) PG8_BAR;
        PG8_WAIT_V(4); PG8_BAR;
        PG8_STAGE(PG8_SB(1, 0), cB + kstep, voffB); PG8_STAGE(PG8_SA(1, 0), cA + kstep, voffA); PG8_STAGE(PG8_SB(1, 1), cB + hstep + kstep, voffB);
        PG8_WAIT_V(6); PG8_BAR;
    }
    for (;;) {
        const bool has_next = S.next(ui + 1, nxt);
        const char* nA = has_next ? (const char*)g.A + (size_t)nxt.pm * tstep : cA; const char* nB = has_next ? (const char*)g.Bt + (size_t)nxt.pn * tstep : cB;
        for (int t = 0; t < nt; t += 2) {
            const bool last = (t == nt - 2);
            const char* a1 = cA + (size_t)(t + 1) * kstep;
            const char* a2 = last ? nA : cA + (size_t)(t + 2) * kstep; const char* b2 = last ? nB : cB + (size_t)(t + 2) * kstep;
            const char* a3 = a2 + kstep; const char* b3 = b2 + kstep;
            if (last && has_next) S.a_ready(nxt);
            if constexpr (SP2) {
            PG8_LDB(B0, 0, 0); PG8_LDB(B1, 0, 1); PG8_SCHED; PG8_LDA(At, 0, 0); PG8_STAGE(PG8_SA(1, 1), a1 + hstep, voffA);
            PG8_WAIT_V(8); PG8_WAIT_L(0); PG8_BAR; PG8_MMA(0, 0, At, B0); PG8_MMA(0, 1, At, B1); PG8_BAR; PG8_SCHED;
            PG8_LDA(At, 0, 1); PG8_STAGE(PG8_SB(0, 0), b2, voffB); PG8_STAGE(PG8_SB(0, 1), b2 + hstep, voffB); PG8_STAGE(PG8_SA(0, 0), a2, voffA);
            PG8_WAIT_V(8); PG8_WAIT_L(0); PG8_BAR; PG8_MMA(1, 0, At, B0); PG8_MMA(1, 1, At, B1); PG8_BAR; PG8_SCHED;
            PG8_LDB(B0, 1, 0); PG8_LDB(B1, 1, 1); PG8_SCHED; PG8_LDA(At, 1, 0); PG8_STAGE(PG8_SA(0, 1), a2 + hstep, voffA);
            PG8_WAIT_V(8); PG8_WAIT_L(0); PG8_BAR; PG8_MMA(0, 0, At, B0); PG8_MMA(0, 1, At, B1); PG8_BAR; PG8_SCHED;
            PG8_LDA(At, 1, 1); PG8_STAGE(PG8_SB(1, 0), b3, voffB); PG8_STAGE(PG8_SB(1, 1), b3 + hstep, voffB); PG8_STAGE(PG8_SA(1, 0), a3, voffA);
            PG8_WAIT_V(8); PG8_WAIT_L(0); PG8_BAR; PG8_MMA(1, 0, At, B0); PG8_MMA(1, 1, At, B1); PG8_BAR; PG8_SCHED;
            } else {
            PG8_LDB(B0, 0, 0); PG8_SCHED; PG8_LDA(At, 0, 0); PG8_STAGE(PG8_SA(1, 1), a1 + hstep, voffA);
            PG8_WAIT_L(8); PG8_BAR; PG8_WAIT_L(0); PG8_MMA(0, 0, At, B0); PG8_BAR; PG8_SCHED;
            PG8_LDB(B1, 0, 1); PG8_STAGE(PG8_SB(0, 0), b2, voffB);
            PG8_BAR; PG8_WAIT_L(0); PG8_MMA(0, 1, At, B1); PG8_BAR;
            PG8_LDA(At, 0, 1); PG8_STAGE(PG8_SA(0, 0), a2, voffA);
            PG8_BAR; PG8_WAIT_L(0); PG8_MMA(1, 0, At, B0); PG8_BAR; PG8_SCHED;
            PG8_STAGE(PG8_SB(0, 1), b2 + hstep, voffB);
            PG8_WAIT_V(6); PG8_BAR; PG8_MMA(1, 1, At, B1); PG8_BAR;
            PG8_LDB(B0, 1, 0); PG8_SCHED; PG8_LDA(At, 1, 0); PG8_STAGE(PG8_SA(0, 1), a2 + hstep, voffA);
            PG8_WAIT_L(8); PG8_BAR; PG8_WAIT_L(0); PG8_MMA(0, 0, At, B0); PG8_BAR; PG8_SCHED;
            PG8_LDB(B1, 1, 1); PG8_STAGE(PG8_SB(1, 0), b3, voffB);
            PG8_BAR; PG8_WAIT_L(0); PG8_MMA(0, 1, At, B1); PG8_BAR;
            PG8_LDA(At, 1, 1); PG8_STAGE(PG8_SA(1, 0), a3, voffA);
            PG8_BAR; PG8_WAIT_L(0); PG8_MMA(1, 0, At, B0); PG8_BAR; PG8_SCHED;
            PG8_STAGE(PG8_SB(1, 1), b3 + hstep, voffB);
            PG8_WAIT_V(6); PG8_BAR; PG8_MMA(1, 1, At, B1); PG8_BAR;
            }
        }
        if constexpr (ALIGN_EPI) { if (wr == 0) PG8_BAR; }
        if constexpr (!Epi::AFTER_DRAIN) { E(acc, cur, wr, wc, fr, fq); S.done(cur); }
        if (!has_next) break;
#pragma unroll
        for (int a = 0; a < 2; ++a)
#pragma unroll
            for (int b = 0; b < 2; ++b)
#pragma unroll
                for (int m = 0; m < 4; ++m)
#pragma unroll
                    for (int n = 0; n < 2; ++n) acc[a][b][m][n] = (f32x4){0.f, 0.f, 0.f, 0.f};
        cur = nxt; cA = nA; cB = nB; ++ui;
        if constexpr (ALIGN_EPI) { if (wr == 1) PG8_BAR; }
    }
    PG8_WAIT_V(0);
    if constexpr (!ALIGN_EPI) { if (wr == 0) PG8_BAR; }
    PG8_BAR;
    if constexpr (Epi::AFTER_DRAIN) { E.fused(acc, cur, wr, wc, fr, fq, lds, wid, lane); S.done(cur); }
#undef PG8_SA
#undef PG8_SB
#undef PG8_STAGE
#undef PG8_LDA
#undef PG8_LDB
#undef PG8_MMA
#undef PG8_WAIT_V
#undef PG8_WAIT_L
#undef PG8_BAR
#undef PG8_SCHED
}
}

constexpr int NWAVES = 8;
constexpr int BATCH = 4, SEQ = 8192, D = 1024, M = BATCH * SEQ, DIN = 5120, FF = 4096, PLE = 256, AW = 512, NH = 8, HD = 64;
constexpr float EPS = 1e-6f;
constexpr int C_Q = 0, C_K = 512, C_V = 1024, C_CB = 1536, C_CC = 2048, C_CU = 2560, C_GA = 3072, C_GC = 4096;
constexpr size_t MiB = 1u << 20;
constexpr size_t WS_WIN = 1 * MiB, WS_WA = 11 * MiB, WS_WC = 12 * MiB, WS_WO = 13 * MiB, WS_WUP = 15 * MiB, WS_WDN = 23 * MiB, WS_WPG = 31 * MiB, WS_WPP = 33 * MiB;
constexpr size_t WS_R1 = 34 * MiB;
constexpr size_t WS_R2 = 98 * MiB;
constexpr size_t WS_R3 = 162 * MiB;
constexpr size_t WS_PB = 482 * MiB;
constexpr size_t WS_XB = 500 * MiB;
constexpr size_t WS_SS2 = 501 * MiB, WS_SS3 = 503 * MiB;
constexpr size_t WS_END = 505 * MiB;
constexpr size_t WS_CNT = 65536;
constexpr int RING_BYTES = 131072, LDS_BYTES = 147456;

#define GAS __attribute__((address_space(1)))
#define LAS __attribute__((address_space(3)))
typedef unsigned short bf16;
typedef unsigned v4u __attribute__((ext_vector_type(4)));
typedef unsigned v2u __attribute__((ext_vector_type(2)));
typedef float f32x4 __attribute__((ext_vector_type(4)));
typedef float f32x16 __attribute__((ext_vector_type(16)));
typedef short bf16x8 __attribute__((ext_vector_type(8)));
using pg8::pk_bf16; using pg8::bf_lo; using pg8::bf_hi;
#define LDS_WAIT() asm volatile("s_waitcnt lgkmcnt(0)" ::: "memory")

#define XB_TMO      128
#define XB_XCNT(j)  (256  + 64 * (j))
#define XB_XSUB(j)  (1280 + 64 * (j))
#define XB_XGEN(j)  (2304 + 64 * (j))
#define XB_TOP      3328
#define XB_TOPGEN   3392
#define XCD_BAR_WORDS 3456
#define XB_SPIN_CAP (1u << 18)

__device__ __forceinline__ unsigned xb_ld(unsigned* p)              { return __hip_atomic_load(p, __ATOMIC_RELAXED, __HIP_MEMORY_SCOPE_AGENT); }
__device__ __forceinline__ unsigned xb_add(unsigned* p, unsigned v) { return __hip_atomic_fetch_add(p, v, __ATOMIC_RELAXED, __HIP_MEMORY_SCOPE_AGENT); }
__device__ __forceinline__ unsigned xb_xcc_id() { return (unsigned)__builtin_amdgcn_s_getreg((3 << 11) | 20) & 0xFu; }
#define XB_SPIN(cond, bar) do { unsigned _sp = 0; while (cond) { __builtin_amdgcn_s_sleep(1); \
    if ((++_sp & 255u) == 0u) { if (xb_ld(&(bar)[XB_TMO])) break; if (_sp > XB_SPIN_CAP) { atomicAdd(&(bar)[XB_TMO], 1u); break; } } } } while (0)

struct XcdBarrier {
    unsigned* bar; unsigned x;
    volatile LAS unsigned* st;
};

__device__ __forceinline__ XcdBarrier xcd_barrier_post(unsigned* bar, volatile LAS unsigned* st) {
    XcdBarrier b; b.bar = bar; b.x = xb_xcc_id(); b.st = st;
    if (threadIdx.x == 0) (void)xb_add(&bar[XB_XCNT(b.x)], 1u);
    return b;
}
__device__ __forceinline__ void xcd_barrier_complete(unsigned* bar, unsigned x, unsigned& nloc, unsigned& nx) {
    const unsigned G = gridDim.x * gridDim.y * gridDim.z;
    unsigned sum, cnt, mine, sp = 0u;
    for (;;) {
        sum = 0u; cnt = 0u; mine = 0u;
#pragma unroll
        for (unsigned j = 0; j < 16; ++j) { const unsigned c = xb_ld(&bar[XB_XCNT(j)]); sum += c; cnt += (c > 0u) ? 1u : 0u; mine = (j == x) ? c : mine; }
        if (sum == G) break;
        __builtin_amdgcn_s_sleep(1);
        if ((++sp & 255u) == 0u) { if (xb_ld(&bar[XB_TMO])) break; if (sp > XB_SPIN_CAP) { atomicAdd(&bar[XB_TMO], 1u); break; } }
    }
    nloc = mine > 0u ? mine : 1u; nx = cnt > 0u ? cnt : 1u;
}

__device__ __forceinline__ void xcd_barrier(const XcdBarrier& b) {
    asm volatile("s_waitcnt vmcnt(0)" ::: "memory");
    __syncthreads();
    if (threadIdx.x == 0) {
        unsigned* bar = b.bar;
        __builtin_amdgcn_s_waitcnt(0);
        unsigned nloc = b.st[0], nx = b.st[1];
        if (nloc == 0u) { xcd_barrier_complete(bar, b.x, nloc, nx); b.st[0] = nloc; b.st[1] = nx; }
        const unsigned old = xb_add(&bar[XB_XSUB(b.x)], 1u);
        const unsigned gen = old / nloc;
        if (old + 1u == (gen + 1u) * nloc) {
            __builtin_amdgcn_fence(__ATOMIC_RELEASE, "agent");
            asm volatile("s_waitcnt vmcnt(0)" ::: "memory");
            const unsigned og = xb_add(&bar[XB_TOP], 1u);
            const unsigned tg = og / nx;
            if (og + 1u == (tg + 1u) * nx) xb_add(&bar[XB_TOPGEN], 1u);
            else XB_SPIN(xb_ld(&bar[XB_TOPGEN]) == tg, bar);
            __builtin_amdgcn_fence(__ATOMIC_ACQUIRE, "agent");
            xb_add(&bar[XB_XGEN(b.x)], 1u);
            asm volatile("s_waitcnt vmcnt(0)" ::: "memory");
        } else {
            XB_SPIN(xb_ld(&bar[XB_XGEN(b.x)]) == gen, bar);
            __builtin_amdgcn_fence(__ATOMIC_ACQUIRE, "agent");
            asm volatile("s_waitcnt vmcnt(0)" ::: "memory");
        }
    }
    __syncthreads();
}


__device__ __forceinline__ float wave_sum(float v) {
#pragma unroll
    for (int o = 1; o < 64; o <<= 1) v += __shfl_xor(v, o);
    return v;
}
__device__ __forceinline__ void p0_transpose_item(const float* W, int K, int N, bf16* WT, LAS float* scr, int item, int lane, const float* gain = nullptr) {
    const int nblk = N / 32, kb = item / nblk, nb = item % nblk, k0 = 64 * kb, n0 = 32 * nb;
#pragma unroll 8
    for (int i = 0; i < 32; ++i) { const int kk = 2 * i + (lane >> 5); float v = W[(size_t)(k0 + kk) * N + n0 + (lane & 31)]; if (gain) v *= gain[k0 + kk]; scr[kk * 33 + (lane & 31)] = v; }
    LDS_WAIT(); asm volatile("" ::: "memory");
    const int c = lane & 7;
#pragma unroll
    for (int j = 0; j < 4; ++j) { const int n = (lane >> 3) + 8 * j; const LAS float* s = scr + (8 * c) * 33 + n;
        v4u o; o.x = pk_bf16(s[0 * 33], s[1 * 33]); o.y = pk_bf16(s[2 * 33], s[3 * 33]); o.z = pk_bf16(s[4 * 33], s[5 * 33]); o.w = pk_bf16(s[6 * 33], s[7 * 33]);
        *(v4u*)(WT + (size_t)(n0 + n) * K + k0 + 8 * c) = o; }
    LDS_WAIT(); asm volatile("" ::: "memory");
}
__device__ __forceinline__ void rms_row_to_bf16(const float* xrow, const float* g, bf16* orow, int lane) {
    const f32x4* xr = (const f32x4*)xrow + lane; const f32x4* gr = (const f32x4*)g + lane;
    f32x4 v[4]; float s = 0.f;
#pragma unroll
    for (int j = 0; j < 4; ++j) { v[j] = xr[64 * j]; s += (v[j].x * v[j].x + v[j].y * v[j].y) + (v[j].z * v[j].z + v[j].w * v[j].w); }
    const float rstd = 1.0f / sqrtf(wave_sum(s) * (1.f / D) + EPS);
    v2u* o8 = (v2u*)orow + lane;
#pragma unroll
    for (int j = 0; j < 4; ++j) { const f32x4 gg = gr[64 * j]; v2u w; w.x = pk_bf16(v[j].x * rstd * gg.x, v[j].y * rstd * gg.y); w.y = pk_bf16(v[j].z * rstd * gg.z, v[j].w * rstd * gg.w); o8[64 * j] = w; }
}
__device__ __forceinline__ void res_norm_row(const bf16* yrow, const float* base, float* out, const float* g1, const float* g2, bf16* xn, int lane) {
    const v2u* yr = (const v2u*)yrow + lane; const f32x4* br = (const f32x4*)base + lane; const f32x4* g1r = (const f32x4*)g1 + lane; const f32x4* g2r = (const f32x4*)g2 + lane;
    f32x4 y[4], x[4]; float s = 0.f;
#pragma unroll
    for (int j = 0; j < 4; ++j) { const v2u w = yr[64 * j]; y[j] = (f32x4){bf_lo(w.x), bf_hi(w.x), bf_lo(w.y), bf_hi(w.y)}; x[j] = br[64 * j];
        s += (y[j].x * y[j].x + y[j].y * y[j].y) + (y[j].z * y[j].z + y[j].w * y[j].w); }
    const float rstd = 1.0f / sqrtf(wave_sum(s) * (1.f / D) + EPS);
    float s2 = 0.f;
#pragma unroll
    for (int j = 0; j < 4; ++j) { const f32x4 gg = g1r[64 * j]; x[j] = x[j] + y[j] * rstd * gg; s2 += (x[j].x * x[j].x + x[j].y * x[j].y) + (x[j].z * x[j].z + x[j].w * x[j].w); }
    f32x4* orow = (f32x4*)out + lane;
#pragma unroll
    for (int j = 0; j < 4; ++j) orow[64 * j] = x[j];
    const float rstd2 = 1.0f / sqrtf(wave_sum(s2) * (1.f / D) + EPS);
    v2u* o8 = (v2u*)xn + lane;
#pragma unroll
    for (int j = 0; j < 4; ++j) { const f32x4 gg = g2r[64 * j]; v2u w; w.x = pk_bf16(x[j].x * rstd2 * gg.x, x[j].y * rstd2 * gg.y); w.y = pk_bf16(x[j].z * rstd2 * gg.z, x[j].w * rstd2 * gg.w); o8[64 * j] = w; }
}

#define MFMA32(a, b, c) __builtin_amdgcn_mfma_f32_32x32x16_bf16((a), (b), (c), 0, 0, 0)
__device__ __forceinline__ void attn_unit(const bf16* __restrict__ PROJ, bf16* __restrict__ O, int b, int h, int qt, int lane) {
    const int r = lane & 31, hh = lane >> 5;
    const size_t rowbase = (size_t)b * SEQ;
    const int t0 = qt * 32;
    const bf16* qp = PROJ + (rowbase + t0 + r) * DIN + C_Q + h * HD + 8 * hh;
    bf16x8 qf[4];
#pragma unroll
    for (int ds = 0; ds < 4; ++ds) qf[ds] = *(const bf16x8*)(qp + 16 * ds);
    f32x16 o0, o1;
#pragma unroll
    for (int i = 0; i < 16; ++i) { o0[i] = 0.f; o1[i] = 0.f; }
    float A = 0.f;
    const float L2E = 1.4426950408889634f, LN2 = 0.6931471805599453f;
    for (int kb = qt; kb >= 0; --kb) {
        const int k0 = kb * 32;
        const bf16* kp = PROJ + (rowbase + k0 + r) * DIN + C_K + h * HD + 8 * hh;
        bf16x8 kf[4];
#pragma unroll
        for (int ds = 0; ds < 4; ++ds) kf[ds] = *(const bf16x8*)(kp + 16 * ds);
        const bf16* vp = PROJ + (rowbase + k0 + 4 * hh) * DIN + C_V + h * HD + r;
        bf16x8 va[2][2];
#pragma unroll
        for (int s = 0; s < 2; ++s)
#pragma unroll
            for (int dh = 0; dh < 2; ++dh)
#pragma unroll
                for (int j = 0; j < 8; ++j) va[s][dh][j] = (short)vp[(size_t)(16 * s + 8 * (j >> 2) + (j & 3)) * DIN + 32 * dh];
        f32x16 st;
#pragma unroll
        for (int i = 0; i < 16; ++i) st[i] = 0.f;
#pragma unroll
        for (int ds = 0; ds < 4; ++ds) st = MFMA32(kf[ds], qf[ds], st);
        const bool diag = (kb == qt);
        float lk[16], lb[16];
#pragma unroll
        for (int i = 0; i < 16; ++i) {
            const float z = st[i] * 0.125f;
            const float e = __builtin_amdgcn_exp2f(-fabsf(z) * L2E);
            const float l = __builtin_amdgcn_logf(1.0f + e) * LN2;
            lb[i] = fminf(z, 0.f) - l;
            lk[i] = -fmaxf(z, 0.f) - l;
            if (diag) { const int kk = (i & 3) + 8 * (i >> 2) + 4 * hh; if (!(kk < r)) { lk[i] = 0.f; lb[i] = -INFINITY; } }
        }
        float within[16], c[4], cp[4];
#pragma unroll
        for (int g = 0; g < 4; ++g) { const float s3 = lk[4 * g + 3], s2 = s3 + lk[4 * g + 2], s1 = s2 + lk[4 * g + 1]; c[g] = s1 + lk[4 * g];
            within[4 * g + 3] = 0.f; within[4 * g + 2] = s3; within[4 * g + 1] = s2; within[4 * g] = s1; }
#pragma unroll
        for (int g = 0; g < 4; ++g) cp[g] = __shfl_xor(c[g], 32);
        const float T0 = c[0] + cp[0], T1 = c[1] + cp[1], T2 = c[2] + cp[2], T3 = c[3] + cp[3];
        float suf[4]; suf[3] = 0.f; suf[2] = T3; suf[1] = T3 + T2; suf[0] = suf[1] + T1;
        const float total = suf[0] + T0;
        float w[16];
#pragma unroll
        for (int g = 0; g < 4; ++g) { const float base = A + suf[g] + (hh == 0 ? cp[g] : 0.f);
#pragma unroll
            for (int i = 0; i < 4; ++i) w[4 * g + i] = __builtin_amdgcn_exp2f((lb[4 * g + i] + (base + within[4 * g + i])) * L2E); }
        v4u p0, p1;
        p0.x = pk_bf16(w[0], w[1]); p0.y = pk_bf16(w[2], w[3]); p0.z = pk_bf16(w[4], w[5]); p0.w = pk_bf16(w[6], w[7]);
        p1.x = pk_bf16(w[8], w[9]); p1.y = pk_bf16(w[10], w[11]); p1.z = pk_bf16(w[12], w[13]); p1.w = pk_bf16(w[14], w[15]);
        const bf16x8 x0 = __builtin_bit_cast(bf16x8, p0), x1 = __builtin_bit_cast(bf16x8, p1);
        o0 = MFMA32(va[0][0], x0, o0); o0 = MFMA32(va[1][0], x1, o0);
        o1 = MFMA32(va[0][1], x0, o1); o1 = MFMA32(va[1][1], x1, o1);
        A += total;
        if (__builtin_amdgcn_ballot_w64(A > -88.0f) == 0ull) break;
    }
    bf16* op = O + (rowbase + t0 + r) * AW + h * HD + 4 * hh;
#pragma unroll
    for (int g = 0; g < 4; ++g) {
        v2u a; a.x = pk_bf16(o0[4 * g], o0[4 * g + 1]); a.y = pk_bf16(o0[4 * g + 2], o0[4 * g + 3]); *(v2u*)(op + 8 * g) = a;
        v2u c2; c2.x = pk_bf16(o1[4 * g], o1[4 * g + 1]); c2.y = pk_bf16(o1[4 * g + 2], o1[4 * g + 3]); *(v2u*)(op + 32 + 8 * g) = c2;
    }
}
__device__ __forceinline__ void conv_item(const bf16* __restrict__ PROJ, const float* __restrict__ wconv, bf16* __restrict__ CM, int it) {
    const int cgp = it & 63, run = it >> 6, c0 = cgp * 8; const int t_start = run * 16; const bool first = (t_start % SEQ) == 0;
    f32x4 w0a = *(const f32x4*)(wconv + c0), w0b = *(const f32x4*)(wconv + c0 + 4), w1a = *(const f32x4*)(wconv + AW + c0), w1b = *(const f32x4*)(wconv + AW + c0 + 4),
          w2a = *(const f32x4*)(wconv + 2 * AW + c0), w2b = *(const f32x4*)(wconv + 2 * AW + c0 + 4);
    f32x4 m2a = {0.f, 0.f, 0.f, 0.f}, m2b = m2a, m1a = m2a, m1b = m2a;
    if (!first) {
        f32x4 a0, a1, b0, b1;
        pg8::unpack8(*(const v4u*)(PROJ + (size_t)(t_start - 2) * DIN + C_CC + c0), a0, a1); pg8::unpack8(*(const v4u*)(PROJ + (size_t)(t_start - 2) * DIN + C_CU + c0), b0, b1); m2a = a0 * b0; m2b = a1 * b1;
        pg8::unpack8(*(const v4u*)(PROJ + (size_t)(t_start - 1) * DIN + C_CC + c0), a0, a1); pg8::unpack8(*(const v4u*)(PROJ + (size_t)(t_start - 1) * DIN + C_CU + c0), b0, b1); m1a = a0 * b0; m1b = a1 * b1;
    }
#pragma unroll 4
    for (int t = 0; t < 16; ++t) {
        const bf16* rowp = PROJ + (size_t)(t_start + t) * DIN + c0;
        f32x4 a0, a1, b0, b1, g0, g1;
        pg8::unpack8(*(const v4u*)(rowp + C_CC), a0, a1); pg8::unpack8(*(const v4u*)(rowp + C_CU), b0, b1); pg8::unpack8(*(const v4u*)(rowp + C_CB), g0, g1);
        const f32x4 ma = a0 * b0, mb = a1 * b1;
        const f32x4 ra = g0 * (w0a * m2a + w1a * m1a + w2a * ma), rb = g1 * (w0b * m2b + w1b * m1b + w2b * mb);
        *(v4u*)(CM + (size_t)(t_start + t) * AW + c0) = pg8::pack8(ra, rb);
        m2a = m1a; m2b = m1b; m1a = ma; m1b = mb;
    }
}

struct Args { const float* in[17]; float* out; unsigned char* ws; int ph_lo, ph_hi; };
__global__ void __launch_bounds__(NWAVES * 64, 2) fwd_megakernel(Args args) {
    extern __shared__ __attribute__((aligned(16))) unsigned char lds_raw[];
    LAS unsigned char* lds = (LAS unsigned char*)lds_raw;
    cg::grid_group grid = cg::this_grid();
    const int tid = threadIdx.x, lane = tid & 63, wave = __builtin_amdgcn_readfirstlane(tid >> 6);
    const int G = gridDim.x, bx = blockIdx.x;
    const int gw = bx * NWAVES + wave, NGW = G * NWAVES;
    unsigned char* ws = args.ws;
#define xin ((const float*)args.in[0])
#define pin ((const float*)args.in[1])
#define g_pre_mix ((const float*)args.in[2])
#define w_in ((const float*)args.in[3])
#define b_gate ((const float*)args.in[4])
#define w_conv ((const float*)args.in[5])
#define w_attn_out ((const float*)args.in[6])
#define w_conv_out ((const float*)args.in[7])
#define w_o ((const float*)args.in[8])
#define g_post_mix ((const float*)args.in[9])
#define g_pre_mlp ((const float*)args.in[10])
#define w_up ((const float*)args.in[11])
#define w_down ((const float*)args.in[12])
#define g_post_mlp ((const float*)args.in[13])
#define g_ple ((const float*)args.in[14])
#define w_ple_gate ((const float*)args.in[15])
#define w_ple_proj ((const float*)args.in[16])
    float* out = args.out;
    bf16* Win_t = (bf16*)(ws + WS_WIN); bf16* Wa_t = (bf16*)(ws + WS_WA); bf16* Wc_t = (bf16*)(ws + WS_WC); bf16* Wo_t = (bf16*)(ws + WS_WO);
    bf16* Wup_t = (bf16*)(ws + WS_WUP); bf16* Wdn_t = (bf16*)(ws + WS_WDN); bf16* Wpg_t = (bf16*)(ws + WS_WPG); bf16* Wpp_t = (bf16*)(ws + WS_WPP);
    bf16* R1 = (bf16*)(ws + WS_R1); bf16* R2 = (bf16*)(ws + WS_R2); bf16* R3 = (bf16*)(ws + WS_R3); bf16* PB = (bf16*)(ws + WS_PB);
    bf16* XN = R1; bf16* MB = R1; bf16* PPB = R1;
    bf16* OB = R2; bf16* CM = R2 + (size_t)M * AW; bf16* XB = R2;
    float* SS2 = (float*)(ws + WS_SS2); float* SS3 = (float*)(ws + WS_SS3);
    bf16* PROJ = R3; bf16* HB = R3;
    const int lo = args.ph_lo, hi = args.ph_hi;
    volatile LAS unsigned* bst = (volatile LAS unsigned*)(lds + RING_BYTES + 384);
    if (tid < 2) bst[tid] = 0u;
    __syncthreads();
    if (lo < 0) grid.sync();
    XcdBarrier bar; bar.bar = (unsigned*)ws; bar.x = 0; bar.st = bst;
    if (hi - lo > 1) bar = xcd_barrier_post((unsigned*)ws, bst);
#ifndef PROBE_DUP_MASK
#define PROBE_DUP_MASK 0
#endif
#ifndef PROBE_DUP_SYNC
#define PROBE_DUP_SYNC 0
#endif
#define IN(k) (lo <= (k) && (k) < hi)
#define REP(k) for (int rep_ = 0; rep_ < (((PROBE_DUP_MASK >> (k)) & 1) ? 2 : 1); ++rep_)
#define SEAM(k) do { if (IN(k) && IN((k) + 1)) { xcd_barrier(bar); if (PROBE_DUP_SYNC) xcd_barrier(bar); } } while (0)

    constexpr int I_IN = (D / 64) * (DIN / 32), I_A = (AW / 64) * (D / 32), I_O = (D / 64) * (D / 32), I_UP = (D / 64) * (FF / 32), I_DN = (FF / 64) * (D / 32), I_PP = (PLE / 64) * (D / 32);
    if (IN(0)) REP(0) {
        LAS float* scr = (LAS float*)(lds + wave * 16384);
        for (int it = gw; it < I_IN; it += NGW) p0_transpose_item(w_in, D, DIN, Win_t, scr, it, lane);
        for (int m = gw; m < M; m += NGW) rms_row_to_bf16(xin + (size_t)m * D, g_pre_mix, XN + (size_t)m * D, lane);
        __syncthreads();
    }
    SEAM(0);
    if (IN(1)) REP(1) {
        pg8::Gemm g{XN, Win_t, M, DIN, D}; pg8::StaticOrder S; S.init(M, DIN, G, bx);
        pg8::EpiTile8<pg8::FProj> E{{PROJ, b_gate}};
        pg8::gemm_phase<pg8::EpiTile8<pg8::FProj>, pg8::StaticOrder, true, true>(lds, g, S, E);
    }
    SEAM(1);
    if (IN(2)) REP(2) {
        constexpr int NQT = SEQ / 32, NUNITS = BATCH * NH * NQT;
        for (int pass = 0; pass < 2; ++pass) {
            if ((pass ^ wave) & 1) {
                LAS float* scr = (LAS float*)(lds + wave * 16384);
                constexpr int NITEMS = 2 * I_A + 2 * I_O + I_UP + I_DN + I_PP;
                for (int it = gw; it < NITEMS; it += NGW) {
                    int r = it;
                    if (r < I_A) { p0_transpose_item(w_attn_out, AW, D, Wa_t, scr, r, lane); continue; } r -= I_A;
                    if (r < I_A) { p0_transpose_item(w_conv_out, AW, D, Wc_t, scr, r, lane); continue; } r -= I_A;
                    if (r < I_O) { p0_transpose_item(w_o, D, D, Wo_t, scr, r, lane); continue; } r -= I_O;
                    if (r < I_UP) { p0_transpose_item(w_up, D, FF, Wup_t, scr, r, lane, g_pre_mlp); continue; } r -= I_UP;
                    if (r < I_DN) { p0_transpose_item(w_down, FF, D, Wdn_t, scr, r, lane); continue; } r -= I_DN;
                    if (r < I_O) { p0_transpose_item(w_ple_gate, D, D, Wpg_t, scr, r, lane, g_ple); continue; } r -= I_O;
                    p0_transpose_item(w_ple_proj, PLE, D, Wpp_t, scr, r, lane);
                }
                for (int it = gw * 64 + lane; it < (M / 16) * 64; it += NGW * 64) conv_item(PROJ, w_conv, CM, it);
                for (int i = gw * 64 + lane; i < M * PLE / 8; i += NGW * 64) {
                    const f32x4 a = *(const f32x4*)(pin + (size_t)i * 8), b2 = *(const f32x4*)(pin + (size_t)i * 8 + 4);
                    *(v4u*)(PB + (size_t)i * 8) = pg8::pack8(a, b2);
                }
            } else {
                for (int u = gw; u < NUNITS; u += NGW) { const int qt = u % NQT, bh = u / NQT; attn_unit(PROJ, OB, bh / NH, bh % NH, qt, lane); }
            }
        }
        __syncthreads();
    }
    SEAM(2);
    if (IN(3)) REP(3) {
        { pg8::Gemm g{OB, Wa_t, M, D, AW}; pg8::StaticOrder S; S.init(M, D, G, bx);
          pg8::EpiTile8<pg8::FMixA> E{{MB, PROJ + C_GA}};
          pg8::gemm_phase<pg8::EpiTile8<pg8::FMixA>, pg8::StaticOrder, true, true>(lds, g, S, E); }
        { pg8::Gemm g{CM, Wc_t, M, D, AW}; pg8::StaticOrder S; S.init(M, D, G, bx);
          pg8::EpiTile8<pg8::FMixC> E{{MB, PROJ + C_GC}};
          pg8::gemm_phase<pg8::EpiTile8<pg8::FMixC>, pg8::StaticOrder, true, true>(lds, g, S, E); }
    }
    SEAM(3);
    if (IN(4)) REP(4) {
        pg8::Gemm g{MB, Wo_t, M, D, D}; pg8::StaticOrder S; S.init(M, D, G, bx);
        pg8::PanelRms s1{(unsigned*)(ws + WS_XB), (unsigned*)(ws + WS_CNT), EPS};
        pg8::EpiRmsRes<false> E{xin, XB, g_post_mix, SS2, s1, lds + RING_BYTES + 1024};
        pg8::gemm_phase<pg8::EpiRmsRes<false>, pg8::StaticOrder, true, true>(lds, g, S, E);
    }
    SEAM(4);
    if (IN(6)) REP(6) {
        for (int pass = 0; pass < 2; ++pass) {
            pg8::Gemm g = pass ? pg8::Gemm{XB, Wup_t, M, FF, D} : pg8::Gemm{PB, Wpp_t, M, D, PLE};
            pg8::StaticOrder S; S.init(M, pass ? FF : D, G, bx);
            pg8::EpiTile8<pg8::FStoreRt> E{{pass ? HB : PPB, pass ? FF : D, pass, SS2, EPS}};
            pg8::gemm_phase<pg8::EpiTile8<pg8::FStoreRt>, pg8::StaticOrder, true, true>(lds, g, S, E);
        }
    }
    SEAM(6);
    if (IN(7)) REP(7) {
        pg8::Gemm g{HB, Wdn_t, M, D, FF}; pg8::StaticOrder S; S.init(M, D, G, bx);
        pg8::PanelRms s1{(unsigned*)(ws + WS_XB + 512 * 1024), (unsigned*)(ws + WS_CNT + 32768), EPS};
        pg8::EpiRmsRes<true> E{XB, XB, g_post_mlp, SS3, s1, lds + RING_BYTES + 1024};
        pg8::gemm_phase<pg8::EpiRmsRes<true>, pg8::StaticOrder, true, true>(lds, g, S, E);
    }
    SEAM(7);
    if (IN(9)) REP(9) {
        pg8::Gemm g{XB, Wpg_t, M, D, D}; pg8::StaticOrder S; S.init(M, D, G, bx);
        pg8::EpiTile8<pg8::FFinal> E{{XB, out, PPB, SS3, EPS}};
        pg8::gemm_phase<pg8::EpiTile8<pg8::FFinal>, pg8::StaticOrder, true, true>(lds, g, S, E);
    }
#undef IN
#undef SEAM
#undef xin
#undef pin
#undef g_pre_mix
#undef w_in
#undef b_gate
#undef w_conv
#undef w_attn_out
#undef w_conv_out
#undef w_o
#undef g_post_mix
#undef g_pre_mlp
#undef w_up
#undef w_down
#undef g_post_mlp
#undef g_ple
#undef w_ple_gate
#undef w_ple_proj
}

#ifndef MK_N_LAUNCHES
#define MK_N_LAUNCHES 1
#endif
constexpr int N_PHASES = 10;
extern "C" void kernel_launch(void* const* d_in, const int* in_sizes, int n_in, void* d_out, int out_size, void* d_ws, size_t ws_size, hipStream_t stream) {
    static int grid = 0;
    if (grid == 0) {
        if (n_in != 17 || in_sizes[0] != M * D || out_size != M * D || ws_size < WS_END) { fprintf(stderr, "kernel_launch: unexpected shapes (n_in %d, in0 %d, out %d, ws %zu)\n", n_in, n_in > 0 ? in_sizes[0] : -1, out_size, ws_size); grid = -1; return; }
        int dev = 0, cus = 0, per_cu = 0;
        hipGetDevice(&dev); hipDeviceGetAttribute(&cus, hipDeviceAttributeMultiprocessorCount, dev);
        if (hipFuncSetAttribute((const void*)fwd_megakernel, hipFuncAttributeMaxDynamicSharedMemorySize, LDS_BYTES) != hipSuccess) { fprintf(stderr, "kernel_launch: hipFuncSetAttribute failed\n"); grid = -1; return; }
        if (hipOccupancyMaxActiveBlocksPerMultiprocessor(&per_cu, (const void*)fwd_megakernel, NWAVES * 64, LDS_BYTES) != hipSuccess || per_cu < 1) { fprintf(stderr, "kernel_launch: occupancy query says %d\n", per_cu); per_cu = 1; }
        (void)hipGetLastError();
        grid = cus * per_cu;
        fprintf(stderr, "kernel_launch: grid %d (cus %d x %d)\n", grid, cus, per_cu);
    }
    if (grid < 0) return;
    Args a{};
    for (int i = 0; i < 17; ++i) a.in[i] = (const float*)d_in[i];
    a.out = (float*)d_out; a.ws = (unsigned char*)d_ws;
#if MK_N_LAUNCHES == 1
    a.ph_lo = 0; a.ph_hi = N_PHASES;
    if (hipMemsetAsync(d_ws, 0, 262144, stream) != hipSuccess) { fprintf(stderr, "kernel_launch: memset failed\n"); return; }
    void* kargs[] = {&a};
    hipError_t e = hipLaunchCooperativeKernel((const void*)fwd_megakernel, dim3(grid), dim3(NWAVES * 64), kargs, LDS_BYTES, stream);
    if (e != hipSuccess) fprintf(stderr, "cooperative launch failed: %s (grid %d)\n", hipGetErrorString(e), grid);
#else
    for (int ph = 0; ph < N_PHASES; ++ph) { a.ph_lo = ph; a.ph_hi = ph + 1; hipLaunchKernelGGL(fwd_megakernel, dim3(grid), dim3(NWAVES * 64), LDS_BYTES, stream, a); }
#endif
}
```

```cpp
#include <hip/hip_runtime.h>
#include <hip/hip_cooperative_groups.h>
#include <cstdio>
#include <cstdint>
namespace cg = cooperative_groups;
namespace pg8 {
#define PG8_LAS __attribute__((address_space(3)))
typedef unsigned short bf16_t;
typedef short bf16x8 __attribute__((ext_vector_type(8)));
typedef float f32x4 __attribute__((ext_vector_type(4)));
typedef unsigned u32x4 __attribute__((ext_vector_type(4)));
constexpr int BM = 256, BK = 64, HALF = 128, HTB = HALF * BK * 2  , STAGE_BYTES = 8 * HTB, NXCD = 8, WGM = 8;

__host__ __device__ __forceinline__ int lds_byte(int r, int c) { const int st = (r >> 4) * 2 + (c >> 5), rr = r & 15, cc = c & 31, ob = rr * 64 + cc * 2; return st * 1024 + (ob ^ (((ob >> 9) & 1) << 5)); }
__host__ __device__ __forceinline__ void stage_rc(int b, int& R, int& C) { const int st = b / 1024, sb = b % 1024, swz = sb ^ (((sb >> 9) & 1) << 5); R = (st >> 1) * 16 + swz / 64; C = (st & 1) * 32 + (swz % 64) / 2; }
__host__ __device__ __forceinline__ int perm32(int rho) { const int n = rho >> 4, i = rho & 15; return 8 * (i >> 2) + 4 * n + (i & 3); }

struct Unit { int pm, pn; };
struct Gemm { const bf16_t* A; const bf16_t* Bt; int M, N, K; };

struct StaticOrder {
    int nM, nN, nwg, G, c;
    __host__ __device__ void init(int M, int N, int G_, int c_) { nM = M / BM; nN = N / BM; nwg = nM * nN; G = G_; c = c_; }
    __host__ __device__ bool next(int i, Unit& u) const {
        const long L = (long)i * G + c; if (L >= nwg) return false;
        int wgid = (int)L; { const int q = nwg / NXCD, r = nwg % NXCD, xcd = wgid % NXCD, off = wgid / NXCD; wgid = (xcd < r ? xcd * (q + 1) : r * (q + 1) + (xcd - r) * q) + off; }
        const int nig = WGM * nN, gid = wgid / nig, fm = gid * WGM, gsz = (nM - fm) < WGM ? (nM - fm) : WGM;
        u.pm = fm + ((wgid % nig) % gsz); u.pn = (wgid % nig) / gsz; return true;
    }
    __device__ __forceinline__ void a_ready(const Unit&) const {}
    __device__ __forceinline__ void done(const Unit&) const {}
};

__device__ __forceinline__ unsigned cvt_pk_bf16(float lo, float hi) { unsigned r; asm volatile("v_cvt_pk_bf16_f32 %0, %1, %2" : "=v"(r) : "v"(lo), "v"(hi)); return r; }
typedef float f32x2 __attribute__((ext_vector_type(2)));
typedef __bf16 bf16x2_t __attribute__((ext_vector_type(2)));
__device__ __forceinline__ unsigned pk_bf16(float lo, float hi) { f32x2 v = {lo, hi}; bf16x2_t b = __builtin_convertvector(v, bf16x2_t); return __builtin_bit_cast(unsigned, b); }
__device__ __forceinline__ float bf_lo(unsigned w) { return __uint_as_float(w << 16); }
__device__ __forceinline__ float bf_hi(unsigned w) { return __uint_as_float(w & 0xffff0000u); }
__device__ __forceinline__ float sigmoidf_fast(float x) { return __builtin_amdgcn_rcpf(1.0f + __builtin_amdgcn_exp2f(-1.4426950408889634f * x)); }
__device__ __forceinline__ u32x4 pack8(const f32x4 a, const f32x4 b) { u32x4 w; w.x = pk_bf16(a[0], a[1]); w.y = pk_bf16(a[2], a[3]); w.z = pk_bf16(b[0], b[1]); w.w = pk_bf16(b[2], b[3]); return w; }
__device__ __forceinline__ void unpack8(const u32x4 w, f32x4& a, f32x4& b) { a = (f32x4){bf_lo(w.x), bf_hi(w.x), bf_lo(w.y), bf_hi(w.y)}; b = (f32x4){bf_lo(w.z), bf_hi(w.z), bf_lo(w.w), bf_hi(w.w)}; }

template <class F> struct EpiTile8 {
    static constexpr bool PERM = true, AFTER_DRAIN = false, MIDHOOK = F::MIDHOOK;
    F f;
    __device__ __forceinline__ void mid(f32x4 (&acc)[2][2][4][2], const Unit& u, int wr, int wc, int fr, int fq) const {
        if constexpr (F::MIDHOOK) {
            int row0 = u.pm * BM + wr * 64 + fr, col0 = u.pn * BM + wc * 32 + 8 * fq;
            asm volatile("" : "+v"(row0), "+v"(col0));
            float rsv[2][4];
#pragma unroll
            for (int ai = 0; ai < 2; ++ai) {
#pragma unroll
                for (int m = 0; m < 4; ++m) { rsv[ai][m] = 1.f; if constexpr (F::ROWSCALE) rsv[ai][m] = f.rowscale(row0 + ai * HALF + m * 16); }
                if constexpr (F::ROWSCALE) asm volatile("" ::: "memory");
            }
#pragma unroll
            for (int ai = 0; ai < 2; ++ai)
#pragma unroll
                for (int m = 0; m < 4; ++m) {
#pragma unroll
                    for (int bj = 0; bj < 2; ++bj) { f.mid(row0 + ai * HALF + m * 16, col0 + bj * HALF, acc[ai][bj][m][0], acc[ai][bj][m][1], rsv[ai][m]); asm volatile("" ::: "memory"); }
                }
        }
    }
    __device__ __forceinline__ void operator()(const f32x4 (&acc)[2][2][4][2], const Unit& u, int wr, int wc, int fr, int fq) const {
        const int row0 = u.pm * BM + wr * 64 + fr, col0 = u.pn * BM + wc * 32 + 8 * fq;
        float rsv[2][4];
        if constexpr (F::ROWTABLE) {
            PG8_LAS float* S = (PG8_LAS float*)f.tb;
            if (u.pm != f.cached_pm) {
                const int t = (wr * 4 + wc) * 64 + fq * 16 + fr;
                if (t < 256) S[t] = f.rowscale(u.pm * BM + t);
                asm volatile("s_waitcnt lgkmcnt(0)" ::: "memory"); __builtin_amdgcn_s_barrier(); asm volatile("" ::: "memory");
                f.cached_pm = u.pm;
            }
#pragma unroll
            for (int ai = 0; ai < 2; ++ai)
#pragma unroll
                for (int m = 0; m < 4; ++m) rsv[ai][m] = S[ai * HALF + wr * 64 + m * 16 + fr];
        } else {
#pragma unroll
        for (int ai = 0; ai < 2; ++ai) {
#pragma unroll
            for (int m = 0; m < 4; ++m) { rsv[ai][m] = 1.f; if constexpr (F::ROWSCALE && !F::MIDHOOK) rsv[ai][m] = f.rowscale(row0 + ai * HALF + m * 16); }
            if constexpr (F::ROWSCALE && !F::MIDHOOK) asm volatile("" ::: "memory");
        }
        }
        if constexpr (F::PRELOAD) {
#pragma unroll
            for (int ai = 0; ai < 2; ++ai) {
                u32x4 pre[4][2];
#pragma unroll
                for (int m = 0; m < 4; ++m)
#pragma unroll
                    for (int bj = 0; bj < 2; ++bj) pre[m][bj] = f.preload(row0 + ai * HALF + m * 16, col0 + bj * HALF);
                asm volatile("" ::: "memory");
#pragma unroll
                for (int m = 0; m < 4; ++m)
#pragma unroll
                    for (int bj = 0; bj < 2; ++bj) f.finish(row0 + ai * HALF + m * 16, col0 + bj * HALF, acc[ai][bj][m][0], acc[ai][bj][m][1], pre[m][bj]);
                asm volatile("" ::: "memory");
            }
        } else
#pragma unroll
        for (int ai = 0; ai < 2; ++ai)
#pragma unroll
            for (int m = 0; m < 4; ++m) {
                const int row = row0 + ai * HALF + m * 16;
                const float rs = rsv[ai][m];
                if constexpr (F::PAIR) f.pair(row, col0, u.pn, acc[ai][0][m][0], acc[ai][0][m][1], acc[ai][1][m][0], acc[ai][1][m][1]);
                else {
#pragma unroll
                for (int bj = 0; bj < 2; ++bj) f(row, col0 + bj * HALF, u.pn, acc[ai][bj][m][0], acc[ai][bj][m][1], rs);
                }
                if (F::FENCE && (m & 1)) asm volatile("" ::: "memory");
            }
    }
};
__device__ __forceinline__ float rstd16(const float* ssp, int row, float eps) {
    const f32x4* q = (const f32x4*)(ssp + (size_t)row * 16); const f32x4 a = q[0], b = q[1], c = q[2], d = q[3];
    const float t = (((a[0] + a[1]) + (a[2] + a[3])) + ((b[0] + b[1]) + (b[2] + b[3]))) + (((c[0] + c[1]) + (c[2] + c[3])) + ((d[0] + d[1]) + (d[2] + d[3])));
    return 1.0f / sqrtf(t * (1.0f / 1024.0f) + eps);
}
struct FProj { static constexpr bool FENCE = false, ROWSCALE = false, MIDHOOK = false, PAIR = true, ROWTABLE = false, PRELOAD = false; bf16_t* O; const float* bgate;
    __device__ __forceinline__ void pair(int row, int col0, int pn, f32x4 a0, f32x4 a1, f32x4 b0, f32x4 b1) const {
        bf16_t* rowp = O + (size_t)row * 5120;
        if (pn < 8) { *(u32x4*)(rowp + col0) = pack8(a0, a1); *(u32x4*)(rowp + col0 + HALF) = pack8(b0, b1); }
        else { const int c = (col0 & 127) + ((pn - 8) & 3) * 128 + (pn >= 12 ? (pn - 12) / 4 * 512 : 0);
            if (pn < 12) *(u32x4*)(rowp + 2048 + c) = pack8(a0 * b0, a1 * b1);
            else { const f32x4 ba0 = *(const f32x4*)(bgate + c), ba1 = *(const f32x4*)(bgate + c + 4), bc0 = *(const f32x4*)(bgate + 1024 + c), bc1 = *(const f32x4*)(bgate + 1024 + c + 4);
#pragma unroll
                for (int i = 0; i < 4; ++i) {
                    const float dc0 = 1.0f + fminf(__builtin_amdgcn_exp2f(-1.4426950408889634f * (b0[i] + bc0[i])), 1e30f), dc1 = 1.0f + fminf(__builtin_amdgcn_exp2f(-1.4426950408889634f * (b1[i] + bc1[i])), 1e30f);
                    const float da0 = 1.0f + __builtin_amdgcn_exp2f(-1.4426950408889634f * (a0[i] + ba0[i])), da1 = 1.0f + __builtin_amdgcn_exp2f(-1.4426950408889634f * (a1[i] + ba1[i]));
                    a0[i] = dc0 * __builtin_amdgcn_rcpf(da0); a1[i] = dc1 * __builtin_amdgcn_rcpf(da1); b0[i] = __builtin_amdgcn_rcpf(dc0); b1[i] = __builtin_amdgcn_rcpf(dc1); }
                *(u32x4*)(rowp + 3072 + c) = pack8(a0, a1); *(u32x4*)(rowp + 4096 + c) = pack8(b0, b1); } } }
    __device__ __forceinline__ void operator()(int, int, int, f32x4, f32x4, float) const {} };
struct FMix { static constexpr bool FENCE = true, ROWSCALE = false, MIDHOOK = true, PAIR = false, ROWTABLE = false, PRELOAD = true; bf16_t* MB; const bf16_t* GA; const bf16_t* GC;
    __device__ __forceinline__ void mid(int row, int col, f32x4& v0, f32x4& v1, float) const {
        f32x4 a0, a1; unpack8(*(const u32x4*)(GA + (size_t)row * 5120 + col), a0, a1); v0 = v0 * a0; v1 = v1 * a1; }
    __device__ __forceinline__ u32x4 preload(int row, int col) const { return *(const u32x4*)(GC + (size_t)row * 5120 + col); }
    __device__ __forceinline__ void finish(int row, int col, f32x4 v0, f32x4 v1, u32x4 g) const {
        f32x4 c0, c1; unpack8(g, c0, c1);
#pragma unroll
        for (int i = 0; i < 4; ++i) { v0[i] *= fmaxf(c0[i], 1e-30f); v1[i] *= fmaxf(c1[i], 1e-30f); }
        *(u32x4*)(MB + (size_t)row * 1024 + col) = pack8(v0, v1); }
    __device__ __forceinline__ void operator()(int row, int col, int, f32x4 v0, f32x4 v1, float) const {
        f32x4 c0, c1; unpack8(*(const u32x4*)(GC + (size_t)row * 5120 + col), c0, c1);
#pragma unroll
        for (int i = 0; i < 4; ++i) { v0[i] *= fmaxf(c0[i], 1e-30f); v1[i] *= fmaxf(c1[i], 1e-30f); }
        *(u32x4*)(MB + (size_t)row * 1024 + col) = pack8(v0, v1); } };
template <int ACT  > struct FStore { static constexpr bool FENCE = false, ROWSCALE = false, MIDHOOK = false, PAIR = false, ROWTABLE = false, PRELOAD = false; bf16_t* O; int ldc;
    __device__ __forceinline__ void operator()(int row, int col, int, f32x4 v0, f32x4 v1, float) const {
        if (ACT == 1) {
#pragma unroll
            for (int i = 0; i < 4; ++i) { const float a = fmaxf(v0[i], 0.f), b = fmaxf(v1[i], 0.f); v0[i] = a * a; v1[i] = b * b; } }
        if (ACT == 2) {
#pragma unroll
            for (int i = 0; i < 4; ++i) { v0[i] = sigmoidf_fast(v0[i]); v1[i] = sigmoidf_fast(v1[i]); } }
        *(u32x4*)(O + (size_t)row * ldc + col) = pack8(v0, v1); } };
struct FStoreRt { static constexpr bool FENCE = false, ROWSCALE = true, MIDHOOK = false, PAIR = false, ROWTABLE = true, PRELOAD = false; bf16_t* O; int ldc; int act; const float* ssp; float eps; PG8_LAS unsigned char* tb; mutable int cached_pm;
    __device__ __forceinline__ float rowscale(int row) const { return act == 1 ? rstd16(ssp, row, eps) : 1.f; }
    __device__ __forceinline__ void operator()(int row, int col, int, f32x4 v0, f32x4 v1, float rs) const {
        if (act == 1) {
#pragma unroll
            for (int i = 0; i < 4; ++i) { const float a = fmaxf(v0[i] * rs, 0.f), b = fmaxf(v1[i] * rs, 0.f); v0[i] = a * a; v1[i] = b * b; } }
        *(u32x4*)(O + (size_t)row * ldc + col) = pack8(v0, v1); } };
struct FFinal { static constexpr bool FENCE = true, ROWSCALE = true, MIDHOOK = true, PAIR = false, ROWTABLE = false, PRELOAD = false; const bf16_t* X2; float* out; bf16_t* GB; const float* ssp; float eps; const PG8_LAS float* tab; int pm0, use_tab;
    __device__ __forceinline__ float rowscale(int row) const { return use_tab ? tab[(((row >> 8) == pm0) ? 0 : 256) + (row & 255)] : rstd16(ssp, row, eps); }
    __device__ __forceinline__ void mid(int row, int col, f32x4& v0, f32x4& v1, float rs) const {
#pragma unroll
        for (int i = 0; i < 4; ++i) { v0[i] = sigmoidf_fast(v0[i] * rs); v1[i] = sigmoidf_fast(v1[i] * rs); }
        *(u32x4*)(GB + (size_t)row * 1024 + col) = pack8(v0, v1);
        v0 = (f32x4){0.f, 0.f, 0.f, 0.f}; v1 = v0; }
    __device__ __forceinline__ void operator()(int row, int col, int, f32x4 v0, f32x4 v1, float) const {
        f32x4 g0, g1, x0, x1; unpack8(*(const u32x4*)(GB + (size_t)row * 1024 + col), g0, g1); unpack8(*(const u32x4*)(X2 + (size_t)row * 1024 + col), x0, x1);
        float* p = out + (size_t)row * 1024 + col;
        *(f32x4*)p = x0 + g0 * v0; *(f32x4*)(p + 4) = x1 + g1 * v1; } };

struct PanelRms {
    unsigned* xbuf;
    unsigned* cnt;
    float eps;
    __device__ __forceinline__ void run(const f32x4 (&v)[2][2][4][2], const Unit& u, int wr, int wc, int fr, int fq, PG8_LAS unsigned char* tb, int wid, int lane) const {
        PG8_LAS float* P = (PG8_LAS float*)tb;
        PG8_LAS float* S = (PG8_LAS float*)(tb + 4096);
#pragma unroll
        for (int ai = 0; ai < 2; ++ai)
#pragma unroll
            for (int m = 0; m < 4; ++m) {
                float s = 0.f;
#pragma unroll
                for (int bj = 0; bj < 2; ++bj)
#pragma unroll
                    for (int n = 0; n < 2; ++n) { const f32x4 x = v[ai][bj][m][n]; s += (x[0] * x[0] + x[1] * x[1]) + (x[2] * x[2] + x[3] * x[3]); }
                s += __shfl_xor(s, 16); s += __shfl_xor(s, 32);
                if (fq == 0) P[(ai * HALF + wr * 64 + m * 16 + fr) * 4 + wc] = s;
            }
        asm volatile("s_waitcnt lgkmcnt(0)" ::: "memory"); __builtin_amdgcn_s_barrier(); asm volatile("" ::: "memory");
        const int row = wid * 32 + (lane & 31);
        if (lane < 32) {
            const f32x4 a = *(const PG8_LAS f32x4*)(P + row * 4);
            __hip_atomic_store(xbuf + ((size_t)(u.pm * BM + row) * 4 + u.pn), __float_as_uint((a[0] + a[1]) + (a[2] + a[3])), __ATOMIC_RELAXED, __HIP_MEMORY_SCOPE_AGENT);
        }
        asm volatile("s_waitcnt vmcnt(0)" ::: "memory");
        if (lane == 0) __hip_atomic_fetch_add(cnt + 64 * u.pm, 1u, __ATOMIC_RELAXED, __HIP_MEMORY_SCOPE_AGENT);
        if (wid == 0) {
            unsigned sp = 0;
            while ((unsigned)__builtin_amdgcn_readfirstlane(__hip_atomic_load(cnt + 64 * u.pm, __ATOMIC_RELAXED, __HIP_MEMORY_SCOPE_AGENT)) < 32u) { __builtin_amdgcn_s_sleep(2); if (++sp > (1u << 22)) break; }
            __builtin_amdgcn_fence(__ATOMIC_ACQUIRE, "agent");
        }
        asm volatile("s_waitcnt vmcnt(0) lgkmcnt(0)" ::: "memory"); __builtin_amdgcn_s_barrier(); asm volatile("" ::: "memory");
        if (lane < 32) {
            const unsigned* slot = xbuf + (size_t)(u.pm * BM + row) * 4; float t = 0.f;
#pragma unroll
            for (int k = 0; k < 4; ++k) t += __uint_as_float(__hip_atomic_load(slot + k, __ATOMIC_RELAXED, __HIP_MEMORY_SCOPE_AGENT));
            S[row] = 1.0f / sqrtf(t * (1.0f / 1024.0f) + eps);
        }
        asm volatile("s_waitcnt lgkmcnt(0)" ::: "memory"); __builtin_amdgcn_s_barrier(); asm volatile("" ::: "memory");
    }
};
template <bool BASE_BF16> struct EpiRmsRes {
    static constexpr bool PERM = true, AFTER_DRAIN = false, MIDHOOK = false, PAIR = false, ROWTABLE = false, PRELOAD = false;
    const void* base; bf16_t* xb; const float* g1; float* ssp; PanelRms st; PG8_LAS unsigned char* tb;
    __device__ __forceinline__ void operator()(f32x4 (&acc)[2][2][4][2], const Unit& u, int wr, int wc, int fr, int fq) const {
        const int wid = wr * 4 + wc, lane = fq * 16 + fr;
        const PG8_LAS float* S = (const PG8_LAS float*)(tb + 4096);
        const int col0 = u.pn * BM + wc * 32 + 8 * fq;
        u32x4 preb[4][2]; f32x4 pref[2][2][2];
        if (BASE_BF16) {
#pragma unroll
            for (int m = 0; m < 4; ++m)
#pragma unroll
                for (int bj = 0; bj < 2; ++bj) preb[m][bj] = *(const u32x4*)((const bf16_t*)base + (size_t)(u.pm * BM + wr * 64 + m * 16 + fr) * 1024 + col0 + bj * HALF);
        } else {
#pragma unroll
            for (int m = 0; m < 2; ++m)
#pragma unroll
                for (int bj = 0; bj < 2; ++bj) { const float* bp = (const float*)base + (size_t)(u.pm * BM + wr * 64 + m * 16 + fr) * 1024 + col0 + bj * HALF; pref[m][bj][0] = *(const f32x4*)bp; pref[m][bj][1] = *(const f32x4*)(bp + 4); }
        }
        st.run(acc, u, wr, wc, fr, fq, tb, wid, lane);
        f32x4 gv[2][2];
#pragma unroll
        for (int bj = 0; bj < 2; ++bj) { gv[bj][0] = *(const f32x4*)(g1 + col0 + bj * HALF); gv[bj][1] = *(const f32x4*)(g1 + col0 + bj * HALF + 4); }
#pragma unroll
        for (int ai = 0; ai < 2; ++ai)
#pragma unroll
            for (int m = 0; m < 4; ++m) { const int r = ai * HALF + wr * 64 + m * 16 + fr; const float rs = S[r]; const size_t off = (size_t)(u.pm * BM + r) * 1024 + col0; float s = 0.f;
#pragma unroll
                for (int bj = 0; bj < 2; ++bj) { f32x4 b0, b1;
                    if (BASE_BF16 && ai == 0) unpack8(preb[m][bj], b0, b1);
                    else if (BASE_BF16) unpack8(*(const u32x4*)((const bf16_t*)base + off + bj * HALF), b0, b1);
                    else if (ai == 0 && m < 2) { b0 = pref[m][bj][0]; b1 = pref[m][bj][1]; }
                    else { b0 = *(const f32x4*)((const float*)base + off + bj * HALF); b1 = *(const f32x4*)((const float*)base + off + bj * HALF + 4); }
                    const f32x4 a = b0 + acc[ai][bj][m][0] * rs * gv[bj][0], b = b1 + acc[ai][bj][m][1] * rs * gv[bj][1];
                    s += ((a[0] * a[0] + a[1] * a[1]) + (a[2] * a[2] + a[3] * a[3])) + ((b[0] * b[0] + b[1] * b[1]) + (b[2] * b[2] + b[3] * b[3]));
                    *(u32x4*)(xb + off + bj * HALF) = pack8(a, b); }
                s += __shfl_xor(s, 16); s += __shfl_xor(s, 32);
                if (fq == 0) ssp[(size_t)(u.pm * BM + r) * 16 + u.pn * 4 + wc] = s;
                if (m & 1) asm volatile("" ::: "memory"); }
    }
};

template <class Epi, class Sched, bool ALIGN_EPI = false, bool SP2 = false>
__device__ __forceinline__ void gemm_phase(PG8_LAS unsigned char* lds, const Gemm g, const Sched& S, const Epi& E) {
    int tid_ = threadIdx.x; asm volatile("" : "+v"(tid_));
    const int tid = tid_, wid = __builtin_amdgcn_readfirstlane(tid >> 6), lane = tid & 63, wr = wid >> 2, wc = wid & 3, fr = lane & 15, fq = lane >> 4;
    const int K = g.K, nt = K / BK;
    unsigned voffA[2], voffB[2];
#pragma unroll
    for (int i = 0; i < 2; ++i) { int R, C; stage_rc(tid * 16 + i * 8192, R, C); const int Rb = Epi::PERM ? ((R & ~31) + perm32(R & 31)) : R;
        voffA[i] = (unsigned)(R * K + C) * 2u; voffB[i] = (unsigned)(Rb * K + C) * 2u; }
    const size_t kstep = (size_t)(BK * 2);
    const size_t hstep = (size_t)HALF * K * 2;
    const size_t tstep = 2 * hstep;
    const unsigned ldsw = (unsigned)wid * 1024u;
    const int aoff = lds_byte(wr * 64 + fr, fq * 8), boff = lds_byte(wc * 32 + fr, fq * 8);
#define PG8_SA(b, h) (((b) * 2 + (h)) * HTB)
#define PG8_SB(b, h) ((4 + (b) * 2 + (h)) * HTB)
#define PG8_STAGE(bufoff, gbase, voff) do { _Pragma("unroll") for (int _i = 0; _i < 2; ++_i) \
        __builtin_amdgcn_global_load_lds((const unsigned*)((const char*)(gbase) + (voff)[_i]), (PG8_LAS unsigned*)(lds + (bufoff) + ldsw + _i * 8192), 16, 0, 0); } while (0)
#define PG8_LDA(dst, b, h) do { _Pragma("unroll") for (int m = 0; m < 4; ++m) _Pragma("unroll") for (int k = 0; k < 2; ++k) dst[m][k] = *(const PG8_LAS bf16x8*)(lds + PG8_SA(b, h) + aoff + m * 2048 + k * 1024); } while (0)
#define PG8_LDB(dst, b, h) do { _Pragma("unroll") for (int n = 0; n < 2; ++n) _Pragma("unroll") for (int k = 0; k < 2; ++k) dst[n][k] = *(const PG8_LAS bf16x8*)(lds + PG8_SB(b, h) + boff + n * 2048 + k * 1024); } while (0)
#define PG8_MMA(ai, bj, At, Bt) do { __builtin_amdgcn_s_setprio(1); _Pragma("unroll") for (int m = 0; m < 4; ++m) _Pragma("unroll") for (int n = 0; n < 2; ++n) _Pragma("unroll") for (int k = 0; k < 2; ++k) \
        acc[ai][bj][m][n] = __builtin_amdgcn_mfma_f32_16x16x32_bf16(Bt[n][k], At[m][k], acc[ai][bj][m][n], 0, 0, 0); __builtin_amdgcn_s_setprio(0); } while (0)
#define PG8_WAIT_V(n) asm volatile("s_waitcnt vmcnt(" #n ")" ::: "memory")
#define PG8_WAIT_L(n) asm volatile("s_waitcnt lgkmcnt(" #n ")" ::: "memory")
#define PG8_BAR __builtin_amdgcn_s_barrier()
#define PG8_SCHED __builtin_amdgcn_sched_barrier(0)
    Unit cur, nxt; int ui = 0;
    if (!S.next(0, cur)) return;
    f32x4 acc[2][2][4][2];
#pragma unroll
    for (int a = 0; a < 2; ++a)
#pragma unroll
        for (int b = 0; b < 2; ++b)
#pragma unroll
            for (int m = 0; m < 4; ++m)
#pragma unroll
                for (int n = 0; n < 2; ++n) acc[a][b][m][n] = (f32x4){0.f, 0.f, 0.f, 0.f};
    bf16x8 At[4][2], B0[2][2], B1[2][2];
    const char* cA = (const char*)g.A + (size_t)cur.pm * tstep; const char* cB = (const char*)g.Bt + (size_t)cur.pn * tstep;
    S.a_ready(cur);
    if constexpr (SP2) {
        PG8_STAGE(PG8_SB(0, 0), cB, voffB); PG8_STAGE(PG8_SB(0, 1), cB + hstep, voffB); PG8_STAGE(PG8_SA(0, 0), cA, voffA); PG8_STAGE(PG8_SA(0, 1), cA + hstep, voffA);
        if (wr == 1) PG8_BAR;
        PG8_WAIT_V(2); PG8_BAR;
        PG8_STAGE(PG8_SB(1, 0), cB + kstep, voffB); PG8_STAGE(PG8_SA(1, 0), cA + kstep, voffA); PG8_STAGE(PG8_SB(1, 1), cB + hstep + kstep, voffB);
        PG8_WAIT_V(6); PG8_BAR;
    } else {
        PG8_STAGE(PG8_SB(0, 0), cB, voffB); PG8_STAGE(PG8_SA(0, 0), cA, voffA); PG8_STAGE(PG8_SB(0, 1), cB + hstep, voffB); PG8_STAGE(PG8_SA(0, 1), cA + hstep, voffA);
        if (wr == 1) PG8_BAR;
        PG8_WAIT_V(4); PG8_BAR;
        PG8_STAGE(PG8_SB(1, 0), cB + kstep, voffB); PG8_STAGE(PG8_SA(1, 0), cA + kstep, voffA); PG8_STAGE(PG8_SB(1, 1), cB + hstep + kstep, voffB);
        PG8_WAIT_V(6); PG8_BAR;
    }
    for (;;) {
        const bool has_next = S.next(ui + 1, nxt);
        const char* nA = has_next ? (const char*)g.A + (size_t)nxt.pm * tstep : cA; const char* nB = has_next ? (const char*)g.Bt + (size_t)nxt.pn * tstep : cB;
        for (int t = 0; t < nt; t += 2) {
            const bool last = (t == nt - 2);
            const char* a1 = cA + (size_t)(t + 1) * kstep;
            const char* a2 = last ? nA : cA + (size_t)(t + 2) * kstep; const char* b2 = last ? nB : cB + (size_t)(t + 2) * kstep;
            const char* a3 = a2 + kstep; const char* b3 = b2 + kstep;
            if (last && has_next) S.a_ready(nxt);
            if constexpr (Epi::MIDHOOK) { if (t == (nt >> 1)) E.mid(acc, cur, wr, wc, fr, fq); }
            if constexpr (SP2) {
            PG8_LDB(B0, 0, 0); PG8_LDB(B1, 0, 1); PG8_SCHED; PG8_LDA(At, 0, 0); PG8_STAGE(PG8_SA(1, 1), a1 + hstep, voffA);
            PG8_WAIT_V(8); PG8_WAIT_L(0); PG8_BAR; PG8_MMA(0, 0, At, B0); PG8_MMA(0, 1, At, B1); PG8_BAR; PG8_SCHED;
            PG8_LDA(At, 0, 1); PG8_STAGE(PG8_SB(0, 0), b2, voffB); PG8_STAGE(PG8_SB(0, 1), b2 + hstep, voffB); PG8_STAGE(PG8_SA(0, 0), a2, voffA);
            PG8_WAIT_V(8); PG8_WAIT_L(0); PG8_BAR; PG8_MMA(1, 0, At, B0); PG8_MMA(1, 1, At, B1); PG8_BAR; PG8_SCHED;
            PG8_LDB(B0, 1, 0); PG8_LDB(B1, 1, 1); PG8_SCHED; PG8_LDA(At, 1, 0); PG8_STAGE(PG8_SA(0, 1), a2 + hstep, voffA);
            PG8_WAIT_V(8); PG8_WAIT_L(0); PG8_BAR; PG8_MMA(0, 0, At, B0); PG8_MMA(0, 1, At, B1); PG8_BAR; PG8_SCHED;
            PG8_LDA(At, 1, 1); PG8_STAGE(PG8_SB(1, 0), b3, voffB); PG8_STAGE(PG8_SB(1, 1), b3 + hstep, voffB); PG8_STAGE(PG8_SA(1, 0), a3, voffA);
            PG8_WAIT_V(8); PG8_WAIT_L(0); PG8_BAR; PG8_MMA(1, 0, At, B0); PG8_MMA(1, 1, At, B1); PG8_BAR; PG8_SCHED;
            } else {
            PG8_LDB(B0, 0, 0); PG8_SCHED; PG8_LDA(At, 0, 0); PG8_STAGE(PG8_SA(1, 1), a1 + hstep, voffA);
            PG8_WAIT_L(8); PG8_BAR; PG8_WAIT_L(0); PG8_MMA(0, 0, At, B0); PG8_BAR; PG8_SCHED;
            PG8_LDB(B1, 0, 1); PG8_STAGE(PG8_SB(0, 0), b2, voffB);
            PG8_BAR; PG8_WAIT_L(0); PG8_MMA(0, 1, At, B1); PG8_BAR;
            PG8_LDA(At, 0, 1); PG8_STAGE(PG8_SA(0, 0), a2, voffA);
            PG8_BAR; PG8_WAIT_L(0); PG8_MMA(1, 0, At, B0); PG8_BAR; PG8_SCHED;
            PG8_STAGE(PG8_SB(0, 1), b2 + hstep, voffB);
            PG8_WAIT_V(6); PG8_BAR; PG8_MMA(1, 1, At, B1); PG8_BAR;
            PG8_LDB(B0, 1, 0); PG8_SCHED; PG8_LDA(At, 1, 0); PG8_STAGE(PG8_SA(0, 1), a2 + hstep, voffA);
            PG8_WAIT_L(8); PG8_BAR; PG8_WAIT_L(0); PG8_MMA(0, 0, At, B0); PG8_BAR; PG8_SCHED;
            PG8_LDB(B1, 1, 1); PG8_STAGE(PG8_SB(1, 0), b3, voffB);
            PG8_BAR; PG8_WAIT_L(0); PG8_MMA(0, 1, At, B1); PG8_BAR;
            PG8_LDA(At, 1, 1); PG8_STAGE(PG8_SA(1, 0), a3, voffA);
            PG8_BAR; PG8_WAIT_L(0); PG8_MMA(1, 0, At, B0); PG8_BAR; PG8_SCHED;
            PG8_STAGE(PG8_SB(1, 1), b3 + hstep, voffB);
            PG8_WAIT_V(6); PG8_BAR; PG8_MMA(1, 1, At, B1); PG8_BAR;
            }
        }
        if constexpr (ALIGN_EPI) { if (wr == 0) PG8_BAR; }
        if constexpr (!Epi::AFTER_DRAIN) { E(acc, cur, wr, wc, fr, fq); S.done(cur); }
        if (!has_next) break;
#pragma unroll
        for (int a = 0; a < 2; ++a)
#pragma unroll
            for (int b = 0; b < 2; ++b)
#pragma unroll
                for (int m = 0; m < 4; ++m)
#pragma unroll
                    for (int n = 0; n < 2; ++n) acc[a][b][m][n] = (f32x4){0.f, 0.f, 0.f, 0.f};
        cur = nxt; cA = nA; cB = nB; ++ui;
        if constexpr (ALIGN_EPI) { if (wr == 1) PG8_BAR; }
    }
    PG8_WAIT_V(0);
    if constexpr (!ALIGN_EPI) { if (wr == 0) PG8_BAR; }
    PG8_BAR;
    if constexpr (Epi::AFTER_DRAIN) { E.fused(acc, cur, wr, wc, fr, fq, lds, wid, lane); S.done(cur); }
#undef PG8_SA
#undef PG8_SB
#undef PG8_STAGE
#undef PG8_LDA
#undef PG8_LDB
#undef PG8_MMA
#undef PG8_WAIT_V
#undef PG8_WAIT_L
#undef PG8_BAR
#undef PG8_SCHED
}
struct Gemm2 { const bf16_t* A; const bf16_t* A2; const bf16_t* Bt; int M, N, K, lda, lda2, tsplit; };
template <class Epi, class Sched, bool ALIGN_EPI = false, bool SP2 = false>
__device__ __forceinline__ void gemm_phase_split(PG8_LAS unsigned char* lds, const Gemm2 g, const Sched& S, const Epi& E) {
    int tid_ = threadIdx.x; asm volatile("" : "+v"(tid_));
    const int tid = tid_, wid = __builtin_amdgcn_readfirstlane(tid >> 6), lane = tid & 63, wr = wid >> 2, wc = wid & 3, fr = lane & 15, fq = lane >> 4;
    const int K = g.K, nt = K / BK;
    unsigned voffA[2], voffA2[2], voffB[2]; const int ts = g.tsplit;
#pragma unroll
    for (int i = 0; i < 2; ++i) { int R, C; stage_rc(tid * 16 + i * 8192, R, C); const int Rb = Epi::PERM ? ((R & ~31) + perm32(R & 31)) : R;
        voffA[i] = (unsigned)(R * g.lda + C) * 2u; voffA2[i] = (unsigned)(R * g.lda2 + C) * 2u; voffB[i] = (unsigned)(Rb * K + C) * 2u; }
    const size_t kstep = (size_t)(BK * 2);
    const size_t hstepA = (size_t)HALF * g.lda * 2, hstepA2 = (size_t)HALF * g.lda2 * 2, hstepB = (size_t)HALF * K * 2;
    const size_t tstepA = 2 * hstepA, tstepA2 = 2 * hstepA2, tstepB = 2 * hstepB;
    const unsigned ldsw = (unsigned)wid * 1024u;
    const int aoff = lds_byte(wr * 64 + fr, fq * 8), boff = lds_byte(wc * 32 + fr, fq * 8);
#define PG8_SA(b, h) (((b) * 2 + (h)) * HTB)
#define PG8_SB(b, h) ((4 + (b) * 2 + (h)) * HTB)
#define PG8_STAGE(bufoff, gbase, voff) do { _Pragma("unroll") for (int _i = 0; _i < 2; ++_i) \
        __builtin_amdgcn_global_load_lds((const unsigned*)((const char*)(gbase) + (voff)[_i]), (PG8_LAS unsigned*)(lds + (bufoff) + ldsw + _i * 8192), 16, 0, 0); } while (0)
#define PG8_LDA(dst, b, h) do { _Pragma("unroll") for (int m = 0; m < 4; ++m) _Pragma("unroll") for (int k = 0; k < 2; ++k) dst[m][k] = *(const PG8_LAS bf16x8*)(lds + PG8_SA(b, h) + aoff + m * 2048 + k * 1024); } while (0)
#define PG8_LDB(dst, b, h) do { _Pragma("unroll") for (int n = 0; n < 2; ++n) _Pragma("unroll") for (int k = 0; k < 2; ++k) dst[n][k] = *(const PG8_LAS bf16x8*)(lds + PG8_SB(b, h) + boff + n * 2048 + k * 1024); } while (0)
#define PG8_MMA(ai, bj, At, Bt) do { __builtin_amdgcn_s_setprio(1); _Pragma("unroll") for (int m = 0; m < 4; ++m) _Pragma("unroll") for (int n = 0; n < 2; ++n) _Pragma("unroll") for (int k = 0; k < 2; ++k) \
        acc[ai][bj][m][n] = __builtin_amdgcn_mfma_f32_16x16x32_bf16(Bt[n][k], At[m][k], acc[ai][bj][m][n], 0, 0, 0); __builtin_amdgcn_s_setprio(0); } while (0)
#define PG8_WAIT_V(n) asm volatile("s_waitcnt vmcnt(" #n ")" ::: "memory")
#define PG8_WAIT_L(n) asm volatile("s_waitcnt lgkmcnt(" #n ")" ::: "memory")
#define PG8_BAR __builtin_amdgcn_s_barrier()
#define PG8_SCHED __builtin_amdgcn_sched_barrier(0)
    Unit cur, nxt; int ui = 0;
    if (!S.next(0, cur)) return;
    f32x4 acc[2][2][4][2];
#pragma unroll
    for (int a = 0; a < 2; ++a)
#pragma unroll
        for (int b = 0; b < 2; ++b)
#pragma unroll
            for (int m = 0; m < 4; ++m)
#pragma unroll
                for (int n = 0; n < 2; ++n) acc[a][b][m][n] = (f32x4){0.f, 0.f, 0.f, 0.f};
    bf16x8 At[4][2], B0[2][2], B1[2][2];
    const char* cA = (const char*)g.A + (size_t)cur.pm * tstepA; const char* cA2 = (const char*)g.A2 + (size_t)cur.pm * tstepA2; const char* cB = (const char*)g.Bt + (size_t)cur.pn * tstepB;
    S.a_ready(cur);
    if constexpr (SP2) {
        PG8_STAGE(PG8_SB(0, 0), cB, voffB); PG8_STAGE(PG8_SB(0, 1), cB + hstepB, voffB); PG8_STAGE(PG8_SA(0, 0), cA, voffA); PG8_STAGE(PG8_SA(0, 1), cA + hstepA, voffA);
        if (wr == 1) PG8_BAR;
        PG8_WAIT_V(2); PG8_BAR;
        PG8_STAGE(PG8_SB(1, 0), cB + kstep, voffB); PG8_STAGE(PG8_SA(1, 0), cA + kstep, voffA); PG8_STAGE(PG8_SB(1, 1), cB + hstepB + kstep, voffB);
        PG8_WAIT_V(6); PG8_BAR;
    } else {
        PG8_STAGE(PG8_SB(0, 0), cB, voffB); PG8_STAGE(PG8_SA(0, 0), cA, voffA); PG8_STAGE(PG8_SB(0, 1), cB + hstepB, voffB); PG8_STAGE(PG8_SA(0, 1), cA + hstepA, voffA);
        if (wr == 1) PG8_BAR;
        PG8_WAIT_V(4); PG8_BAR;
        PG8_STAGE(PG8_SB(1, 0), cB + kstep, voffB); PG8_STAGE(PG8_SA(1, 0), cA + kstep, voffA); PG8_STAGE(PG8_SB(1, 1), cB + hstepB + kstep, voffB);
        PG8_WAIT_V(6); PG8_BAR;
    }
    for (;;) {
        const bool has_next = S.next(ui + 1, nxt);
        const char* nA = has_next ? (const char*)g.A + (size_t)nxt.pm * tstepA : cA; const char* nA2 = has_next ? (const char*)g.A2 + (size_t)nxt.pm * tstepA2 : cA2; const char* nB = has_next ? (const char*)g.Bt + (size_t)nxt.pn * tstepB : cB;
        for (int t = 0; t < nt; t += 2) {
            const bool last = (t == nt - 2);
            const bool s1 = (t >= ts), s2 = (!last && t + 2 >= ts);
            const char* a1 = s1 ? cA2 + (size_t)(t + 1 - ts) * kstep : cA + (size_t)(t + 1) * kstep; const size_t h1 = s1 ? hstepA2 : hstepA; const unsigned v1[2] = {s1 ? voffA2[0] : voffA[0], s1 ? voffA2[1] : voffA[1]};
            const char* a2 = last ? nA : (s2 ? cA2 + (size_t)(t + 2 - ts) * kstep : cA + (size_t)(t + 2) * kstep); const size_t h2 = s2 ? hstepA2 : hstepA; const unsigned v2[2] = {s2 ? voffA2[0] : voffA[0], s2 ? voffA2[1] : voffA[1]};
            const char* b2 = last ? nB : cB + (size_t)(t + 2) * kstep;
            const char* a3 = a2 + kstep; const char* b3 = b2 + kstep;
            if (last && has_next) S.a_ready(nxt);
            if (t == ts) E.mid(acc, cur, wr, wc, fr, fq);
            if constexpr (SP2) {
            PG8_LDB(B0, 0, 0); PG8_LDB(B1, 0, 1); PG8_SCHED; PG8_LDA(At, 0, 0); PG8_STAGE(PG8_SA(1, 1), a1 + h1, v1);
            PG8_WAIT_V(8); PG8_WAIT_L(0); PG8_BAR; PG8_MMA(0, 0, At, B0); PG8_MMA(0, 1, At, B1); PG8_BAR; PG8_SCHED;
            PG8_LDA(At, 0, 1); PG8_STAGE(PG8_SB(0, 0), b2, voffB); PG8_STAGE(PG8_SB(0, 1), b2 + hstepB, voffB); PG8_STAGE(PG8_SA(0, 0), a2, v2);
            PG8_WAIT_V(8); PG8_WAIT_L(0); PG8_BAR; PG8_MMA(1, 0, At, B0); PG8_MMA(1, 1, At, B1); PG8_BAR; PG8_SCHED;
            PG8_LDB(B0, 1, 0); PG8_LDB(B1, 1, 1); PG8_SCHED; PG8_LDA(At, 1, 0); PG8_STAGE(PG8_SA(0, 1), a2 + h2, v2);
            PG8_WAIT_V(8); PG8_WAIT_L(0); PG8_BAR; PG8_MMA(0, 0, At, B0); PG8_MMA(0, 1, At, B1); PG8_BAR; PG8_SCHED;
            PG8_LDA(At, 1, 1); PG8_STAGE(PG8_SB(1, 0), b3, voffB); PG8_STAGE(PG8_SB(1, 1), b3 + hstepB, voffB); PG8_STAGE(PG8_SA(1, 0), a3, v2);
            PG8_WAIT_V(8); PG8_WAIT_L(0); PG8_BAR; PG8_MMA(1, 0, At, B0); PG8_MMA(1, 1, At, B1); PG8_BAR; PG8_SCHED;
            } else {
            PG8_LDB(B0, 0, 0); PG8_SCHED; PG8_LDA(At, 0, 0); PG8_STAGE(PG8_SA(1, 1), a1 + h1, v1);
            PG8_WAIT_L(8); PG8_BAR; PG8_WAIT_L(0); PG8_MMA(0, 0, At, B0); PG8_BAR; PG8_SCHED;
            PG8_LDB(B1, 0, 1); PG8_STAGE(PG8_SB(0, 0), b2, voffB);
            PG8_BAR; PG8_WAIT_L(0); PG8_MMA(0, 1, At, B1); PG8_BAR;
            PG8_LDA(At, 0, 1); PG8_STAGE(PG8_SA(0, 0), a2, v2);
            PG8_BAR; PG8_WAIT_L(0); PG8_MMA(1, 0, At, B0); PG8_BAR; PG8_SCHED;
            PG8_STAGE(PG8_SB(0, 1), b2 + hstepB, voffB);
            PG8_WAIT_V(6); PG8_BAR; PG8_MMA(1, 1, At, B1); PG8_BAR;
            PG8_LDB(B0, 1, 0); PG8_SCHED; PG8_LDA(At, 1, 0); PG8_STAGE(PG8_SA(0, 1), a2 + h2, v2);
            PG8_WAIT_L(8); PG8_BAR; PG8_WAIT_L(0); PG8_MMA(0, 0, At, B0); PG8_BAR; PG8_SCHED;
            PG8_LDB(B1, 1, 1); PG8_STAGE(PG8_SB(1, 0), b3, voffB);
            PG8_BAR; PG8_WAIT_L(0); PG8_MMA(0, 1, At, B1); PG8_BAR;
            PG8_LDA(At, 1, 1); PG8_STAGE(PG8_SA(1, 0), a3, v2);
            PG8_BAR; PG8_WAIT_L(0); PG8_MMA(1, 0, At, B0); PG8_BAR; PG8_SCHED;
            PG8_STAGE(PG8_SB(1, 1), b3 + hstepB, voffB);
            PG8_WAIT_V(6); PG8_BAR; PG8_MMA(1, 1, At, B1); PG8_BAR;
            }
        }
        if constexpr (ALIGN_EPI) { if (wr == 0) PG8_BAR; }
        if constexpr (!Epi::AFTER_DRAIN) { E(acc, cur, wr, wc, fr, fq); S.done(cur); }
        if (!has_next) break;
#pragma unroll
        for (int a = 0; a < 2; ++a)
#pragma unroll
            for (int b = 0; b < 2; ++b)
#pragma unroll
                for (int m = 0; m < 4; ++m)
#pragma unroll
                    for (int n = 0; n < 2; ++n) acc[a][b][m][n] = (f32x4){0.f, 0.f, 0.f, 0.f};
        cur = nxt; cA = nA; cA2 = nA2; cB = nB; ++ui;
        if constexpr (ALIGN_EPI) { if (wr == 1) PG8_BAR; }
    }
    PG8_WAIT_V(0);
    if constexpr (!ALIGN_EPI) { if (wr == 0) PG8_BAR; }
    PG8_BAR;
    if constexpr (Epi::AFTER_DRAIN) { E.fused(acc, cur, wr, wc, fr, fq, lds, wid, lane); S.done(cur); }
#undef PG8_SA
#undef PG8_SB
#undef PG8_STAGE
#undef PG8_LDA
#undef PG8_LDB
#undef PG8_MMA
#undef PG8_WAIT_V
#undef PG8_WAIT_L
#undef PG8_BAR
#undef PG8_SCHED
}
}

constexpr int NWAVES = 8;
constexpr int BATCH = 4, SEQ = 8192, D = 1024, M = BATCH * SEQ, DIN = 5120, FF = 4096, PLE = 256, AW = 512, NH = 8, HD = 64;
constexpr float EPS = 1e-6f;
constexpr int C_Q = 0, C_K = 512, C_V = 1024, C_CB = 1536, C_CC = 2048, C_CU = 2560, C_GA = 3072, C_GC = 4096;
constexpr size_t MiB = 1u << 20;
constexpr size_t WS_WIN = 1 * MiB, WS_WA = 11 * MiB, WS_WC = 12 * MiB, WS_WO = 13 * MiB, WS_WUP = 15 * MiB, WS_WDN = 23 * MiB, WS_WPG = 31 * MiB, WS_WPP = 33 * MiB;
constexpr size_t WS_R1 = 34 * MiB;
constexpr size_t WS_R2 = 98 * MiB;
constexpr size_t WS_R3 = 162 * MiB;
constexpr size_t WS_PB = 482 * MiB;
constexpr size_t WS_XB = 500 * MiB;
constexpr size_t WS_SS2 = 501 * MiB, WS_SS3 = 503 * MiB;
constexpr size_t WS_END = 505 * MiB;
constexpr size_t WS_CNT = 65536;
constexpr int RING_BYTES = 131072, LDS_BYTES = 147456;

#define GAS __attribute__((address_space(1)))
#define LAS __attribute__((address_space(3)))
typedef unsigned short bf16;
typedef unsigned v4u __attribute__((ext_vector_type(4)));
typedef unsigned v2u __attribute__((ext_vector_type(2)));
typedef float f32x4 __attribute__((ext_vector_type(4)));
typedef float f32x16 __attribute__((ext_vector_type(16)));
typedef short bf16x8 __attribute__((ext_vector_type(8)));
using pg8::pk_bf16; using pg8::bf_lo; using pg8::bf_hi;
#define LDS_WAIT() asm volatile("s_waitcnt lgkmcnt(0)" ::: "memory")

#define XB_TMO      128
#define XB_XCNT(j)  (256  + 64 * (j))
#define XB_XSUB(j)  (1280 + 64 * (j))
#define XB_XGEN(j)  (2304 + 64 * (j))
#define XB_TOP      3328
#define XB_TOPGEN   3392
#define XCD_BAR_WORDS 3456
#define XB_SPIN_CAP (1u << 18)

__device__ __forceinline__ unsigned xb_ld(unsigned* p)              { return __hip_atomic_load(p, __ATOMIC_RELAXED, __HIP_MEMORY_SCOPE_AGENT); }
__device__ __forceinline__ unsigned xb_add(unsigned* p, unsigned v) { return __hip_atomic_fetch_add(p, v, __ATOMIC_RELAXED, __HIP_MEMORY_SCOPE_AGENT); }
__device__ __forceinline__ unsigned xb_xcc_id() { return (unsigned)__builtin_amdgcn_s_getreg((3 << 11) | 20) & 0xFu; }
#define XB_SPIN(cond, bar) do { unsigned _sp = 0; while (cond) { __builtin_amdgcn_s_sleep(1); \
    if ((++_sp & 255u) == 0u) { if (xb_ld(&(bar)[XB_TMO])) break; if (_sp > XB_SPIN_CAP) { atomicAdd(&(bar)[XB_TMO], 1u); break; } } } } while (0)

struct XcdBarrier {
    unsigned* bar; unsigned x;
    volatile LAS unsigned* st;
};

__device__ __forceinline__ XcdBarrier xcd_barrier_post(unsigned* bar, volatile LAS unsigned* st) {
    XcdBarrier b; b.bar = bar; b.x = xb_xcc_id(); b.st = st;
    if (threadIdx.x == 0) (void)xb_add(&bar[XB_XCNT(b.x)], 1u);
    return b;
}
__device__ __forceinline__ void xcd_barrier_complete(unsigned* bar, unsigned x, unsigned& nloc, unsigned& nx) {
    const unsigned G = gridDim.x * gridDim.y * gridDim.z;
    unsigned sum, cnt, mine, sp = 0u;
    for (;;) {
        sum = 0u; cnt = 0u; mine = 0u;
#pragma unroll
        for (unsigned j = 0; j < 16; ++j) { const unsigned c = xb_ld(&bar[XB_XCNT(j)]); sum += c; cnt += (c > 0u) ? 1u : 0u; mine = (j == x) ? c : mine; }
        if (sum == G) break;
        __builtin_amdgcn_s_sleep(1);
        if ((++sp & 255u) == 0u) { if (xb_ld(&bar[XB_TMO])) break; if (sp > XB_SPIN_CAP) { atomicAdd(&bar[XB_TMO], 1u); break; } }
    }
    nloc = mine > 0u ? mine : 1u; nx = cnt > 0u ? cnt : 1u;
}

__device__ __forceinline__ void xcd_barrier(const XcdBarrier& b) {
    asm volatile("s_waitcnt vmcnt(0)" ::: "memory");
    __syncthreads();
    if (threadIdx.x == 0) {
        unsigned* bar = b.bar;
        __builtin_amdgcn_s_waitcnt(0);
        unsigned nloc = b.st[0], nx = b.st[1];
        if (nloc == 0u) { xcd_barrier_complete(bar, b.x, nloc, nx); b.st[0] = nloc; b.st[1] = nx; }
        const unsigned old = xb_add(&bar[XB_XSUB(b.x)], 1u);
        const unsigned gen = old / nloc;
        if (old + 1u == (gen + 1u) * nloc) {
            __builtin_amdgcn_fence(__ATOMIC_RELEASE, "agent");
            asm volatile("s_waitcnt vmcnt(0)" ::: "memory");
            const unsigned og = xb_add(&bar[XB_TOP], 1u);
            const unsigned tg = og / nx;
            if (og + 1u == (tg + 1u) * nx) xb_add(&bar[XB_TOPGEN], 1u);
            else XB_SPIN(xb_ld(&bar[XB_TOPGEN]) == tg, bar);
            __builtin_amdgcn_fence(__ATOMIC_ACQUIRE, "agent");
            xb_add(&bar[XB_XGEN(b.x)], 1u);
            asm volatile("s_waitcnt vmcnt(0)" ::: "memory");
        } else {
            XB_SPIN(xb_ld(&bar[XB_XGEN(b.x)]) == gen, bar);
            __builtin_amdgcn_fence(__ATOMIC_ACQUIRE, "agent");
            asm volatile("s_waitcnt vmcnt(0)" ::: "memory");
        }
    }
    __syncthreads();
}


__device__ __forceinline__ float wave_sum(float v) {
#pragma unroll
    for (int o = 1; o < 64; o <<= 1) v += __shfl_xor(v, o);
    return v;
}
__device__ __forceinline__ void p0_transpose_item(const float* W, int K, int N, bf16* WT, LAS float* scr, int item, int lane, const float* gain = nullptr, int ldw = 0, bool permin = false) {
    const int nblk = N / 32, kb = item / nblk, nb = item % nblk, k0 = 64 * kb, n0 = 32 * nb;
    int sn0 = n0;
    if (permin && n0 >= 2048) { const int base = n0 < 3072 ? 2048 : 3072, half = n0 < 3072 ? 512 : 1024, t = n0 - base, j = t >> 8, w = t & 255; sn0 = base + (w < 128 ? 0 : half) + 128 * j + (w & 127); }
    { const int cq = lane & 7;
#pragma unroll
      for (int i = 0; i < 8; ++i) { const int kk = 8 * i + (lane >> 3); f32x4 v = *(const f32x4*)(W + (size_t)(k0 + kk) * N + sn0 + 4 * cq); if (gain) v = v * gain[k0 + kk];
          LAS float* d = scr + kk * 33 + 4 * cq; d[0] = v.x; d[1] = v.y; d[2] = v.z; d[3] = v.w; } }
    LDS_WAIT(); asm volatile("" ::: "memory");
    const int c = lane & 7;
#pragma unroll
    for (int j = 0; j < 4; ++j) { const int n = (lane >> 3) + 8 * j; const LAS float* s = scr + (8 * c) * 33 + n;
        v4u o; o.x = pk_bf16(s[0 * 33], s[1 * 33]); o.y = pk_bf16(s[2 * 33], s[3 * 33]); o.z = pk_bf16(s[4 * 33], s[5 * 33]); o.w = pk_bf16(s[6 * 33], s[7 * 33]);
        *(v4u*)(WT + (size_t)(n0 + n) * (ldw ? ldw : K) + k0 + 8 * c) = o; }
    LDS_WAIT(); asm volatile("" ::: "memory");
}
__device__ __forceinline__ void rms_row_to_bf16(const float* xrow, const float* g, bf16* orow, int lane) {
    const f32x4* xr = (const f32x4*)xrow + lane; const f32x4* gr = (const f32x4*)g + lane;
    f32x4 v[4]; float s = 0.f;
#pragma unroll
    for (int j = 0; j < 4; ++j) { v[j] = xr[64 * j]; s += (v[j].x * v[j].x + v[j].y * v[j].y) + (v[j].z * v[j].z + v[j].w * v[j].w); }
    const float rstd = 1.0f / sqrtf(wave_sum(s) * (1.f / D) + EPS);
    v2u* o8 = (v2u*)orow + lane;
#pragma unroll
    for (int j = 0; j < 4; ++j) { const f32x4 gg = gr[64 * j]; v2u w; w.x = pk_bf16(v[j].x * rstd * gg.x, v[j].y * rstd * gg.y); w.y = pk_bf16(v[j].z * rstd * gg.z, v[j].w * rstd * gg.w); o8[64 * j] = w; }
}
__device__ __forceinline__ void res_norm_row(const bf16* yrow, const float* base, float* out, const float* g1, const float* g2, bf16* xn, int lane) {
    const v2u* yr = (const v2u*)yrow + lane; const f32x4* br = (const f32x4*)base + lane; const f32x4* g1r = (const f32x4*)g1 + lane; const f32x4* g2r = (const f32x4*)g2 + lane;
    f32x4 y[4], x[4]; float s = 0.f;
#pragma unroll
    for (int j = 0; j < 4; ++j) { const v2u w = yr[64 * j]; y[j] = (f32x4){bf_lo(w.x), bf_hi(w.x), bf_lo(w.y), bf_hi(w.y)}; x[j] = br[64 * j];
        s += (y[j].x * y[j].x + y[j].y * y[j].y) + (y[j].z * y[j].z + y[j].w * y[j].w); }
    const float rstd = 1.0f / sqrtf(wave_sum(s) * (1.f / D) + EPS);
    float s2 = 0.f;
#pragma unroll
    for (int j = 0; j < 4; ++j) { const f32x4 gg = g1r[64 * j]; x[j] = x[j] + y[j] * rstd * gg; s2 += (x[j].x * x[j].x + x[j].y * x[j].y) + (x[j].z * x[j].z + x[j].w * x[j].w); }
    f32x4* orow = (f32x4*)out + lane;
#pragma unroll
    for (int j = 0; j < 4; ++j) orow[64 * j] = x[j];
    const float rstd2 = 1.0f / sqrtf(wave_sum(s2) * (1.f / D) + EPS);
    v2u* o8 = (v2u*)xn + lane;
#pragma unroll
    for (int j = 0; j < 4; ++j) { const f32x4 gg = g2r[64 * j]; v2u w; w.x = pk_bf16(x[j].x * rstd2 * gg.x, x[j].y * rstd2 * gg.y); w.y = pk_bf16(x[j].z * rstd2 * gg.z, x[j].w * rstd2 * gg.w); o8[64 * j] = w; }
}

#define MFMA32(a, b, c) __builtin_amdgcn_mfma_f32_32x32x16_bf16((a), (b), (c), 0, 0, 0)
__device__ __forceinline__ void attn_load(const bf16* __restrict__ PROJ, size_t rowbase, int h, int k0, int r, int hh, bf16x8 (&kf)[4], unsigned (&vr)[32]) {
    const bf16* vp = PROJ + (rowbase + k0 + 4 * hh) * DIN + C_V + h * HD + r;
#pragma unroll
    for (int s = 0; s < 2; ++s)
#pragma unroll
        for (int dh = 0; dh < 2; ++dh)
#pragma unroll
            for (int j = 0; j < 8; ++j) vr[(s * 2 + dh) * 8 + j] = vp[(size_t)(16 * s + 8 * (j >> 2) + (j & 3)) * DIN + 32 * dh];
    asm volatile("" ::: "memory");
    const bf16* kp = PROJ + (rowbase + k0 + r) * DIN + C_K + h * HD + 8 * hh;
#pragma unroll
    for (int ds = 0; ds < 4; ++ds) kf[ds] = *(const bf16x8*)(kp + 16 * ds);
}
__device__ __forceinline__ void attn_block(const bf16x8 (&kf)[4], unsigned (&vr)[32], const bf16x8 (&qf)[4], bool diag, int r, int hh, float& A2, f32x16& o0, f32x16& o1,
                                           const bf16* __restrict__ PROJ, size_t rowbase, int h, int knext, bf16x8 (&kfN)[4], unsigned (&vrN)[32]) {
    f32x16 st;
#pragma unroll
    for (int i = 0; i < 16; ++i) st[i] = 0.f;
#pragma unroll
    for (int ds = 0; ds < 4; ++ds) st = MFMA32(kf[ds], qf[ds], st);
    attn_load(PROJ, rowbase, h, knext, r, hh, kfN, vrN);
    { float anchor = st[0];
#pragma unroll
      for (int i = 0; i < 32; ++i) asm volatile("" : "+v"(vr[i]), "+v"(anchor));
      st[0] = anchor; }
    bf16x8 va[2][2];
#pragma unroll
    for (int s = 0; s < 2; ++s)
#pragma unroll
        for (int dh = 0; dh < 2; ++dh) { v4u pk;
            pk.x = vr[(s * 2 + dh) * 8 + 0] | (vr[(s * 2 + dh) * 8 + 1] << 16); pk.y = vr[(s * 2 + dh) * 8 + 2] | (vr[(s * 2 + dh) * 8 + 3] << 16);
            pk.z = vr[(s * 2 + dh) * 8 + 4] | (vr[(s * 2 + dh) * 8 + 5] << 16); pk.w = vr[(s * 2 + dh) * 8 + 6] | (vr[(s * 2 + dh) * 8 + 7] << 16);
            va[s][dh] = __builtin_bit_cast(bf16x8, pk); }
    float lk[16], lb[16];
#pragma unroll
    for (int i = 0; i < 16; ++i) {
        const float z2 = st[i] * (0.125f * 1.4426950408889634f);
        const float l2 = __builtin_amdgcn_logf(1.0f + __builtin_amdgcn_exp2f(-fabsf(z2)));
        lb[i] = fminf(z2, 0.f) - l2;
        lk[i] = lb[i] - z2;
    }
    if (diag) {
#pragma unroll
        for (int i = 0; i < 16; ++i) { const int kk = (i & 3) + 8 * (i >> 2) + 4 * hh; if (!(kk < r)) { lk[i] = 0.f; lb[i] = -INFINITY; } }
    }
    float within[16], c[4], cp[4];
#pragma unroll
    for (int g = 0; g < 4; ++g) { const float s3 = lk[4 * g + 3], s2 = s3 + lk[4 * g + 2], s1 = s2 + lk[4 * g + 1]; c[g] = s1 + lk[4 * g];
        within[4 * g + 3] = 0.f; within[4 * g + 2] = s3; within[4 * g + 1] = s2; within[4 * g] = s1; }
    float Tg[4];
#pragma unroll
    for (int g = 0; g < 4; ++g) {
        const auto rr = __builtin_amdgcn_permlane32_swap(__float_as_uint(c[g]), __float_as_uint(c[g]), false, false);
        const float r0 = __uint_as_float(rr[0]), r1 = __uint_as_float(rr[1]);
        Tg[g] = r0 + r1; cp[g] = r1;
    }
    const float T0 = Tg[0], T1 = Tg[1], T2 = Tg[2], T3 = Tg[3];
    float suf[4]; suf[3] = 0.f; suf[2] = T3; suf[1] = T3 + T2; suf[0] = suf[1] + T1;
    const float total = suf[0] + T0;
    float w[16];
#pragma unroll
    for (int g = 0; g < 4; ++g) { const float base = A2 + suf[g] + (hh == 0 ? cp[g] : 0.f);
#pragma unroll
        for (int i = 0; i < 4; ++i) w[4 * g + i] = __builtin_amdgcn_exp2f(lb[4 * g + i] + (base + within[4 * g + i])); }
    v4u p0, p1;
    p0.x = pk_bf16(w[0], w[1]); p0.y = pk_bf16(w[2], w[3]); p0.z = pk_bf16(w[4], w[5]); p0.w = pk_bf16(w[6], w[7]);
    p1.x = pk_bf16(w[8], w[9]); p1.y = pk_bf16(w[10], w[11]); p1.z = pk_bf16(w[12], w[13]); p1.w = pk_bf16(w[14], w[15]);
    const bf16x8 x0 = __builtin_bit_cast(bf16x8, p0), x1 = __builtin_bit_cast(bf16x8, p1);
    o0 = MFMA32(va[0][0], x0, o0); o0 = MFMA32(va[1][0], x1, o0);
    o1 = MFMA32(va[0][1], x0, o1); o1 = MFMA32(va[1][1], x1, o1);
    A2 += total;
}
__device__ __forceinline__ void attn_unit(const bf16* __restrict__ PROJ, bf16* __restrict__ O, int b, int h, int qt, int lane) {
    const int r = lane & 31, hh = lane >> 5;
    const size_t rowbase = (size_t)b * SEQ;
    const int t0 = qt * 32;
    const bf16* qp = PROJ + (rowbase + t0 + r) * DIN + C_Q + h * HD + 8 * hh;
    bf16x8 qf[4];
#pragma unroll
    for (int ds = 0; ds < 4; ++ds) qf[ds] = *(const bf16x8*)(qp + 16 * ds);
    f32x16 o0, o1;
#pragma unroll
    for (int i = 0; i < 16; ++i) { o0[i] = 0.f; o1[i] = 0.f; }
    float A2 = 0.f;
#define ATT_DONE() (__builtin_amdgcn_ballot_w64(A2 > -127.0f) == 0ull)
    bf16x8 kfA[4], kfB[4]; unsigned vaA[32], vaB[32];
    attn_load(PROJ, rowbase, h, t0, r, hh, kfA, vaA);
    int kb = qt;
    for (;;) {
        attn_block(kfA, vaA, qf, kb == qt, r, hh, A2, o0, o1, PROJ, rowbase, h, (kb > 0 ? kb - 1 : 0) * 32, kfB, vaB);
        if (kb == 0 || ATT_DONE()) break;
        --kb;
        attn_block(kfB, vaB, qf, false, r, hh, A2, o0, o1, PROJ, rowbase, h, (kb > 0 ? kb - 1 : 0) * 32, kfA, vaA);
        if (kb == 0 || ATT_DONE()) break;
        --kb;
    }
#undef ATT_DONE
    bf16* op = O + (rowbase + t0 + r) * D + h * HD + 4 * hh;
#pragma unroll
    for (int g = 0; g < 4; ++g) {
        v2u a; a.x = pk_bf16(o0[4 * g], o0[4 * g + 1]); a.y = pk_bf16(o0[4 * g + 2], o0[4 * g + 3]); *(v2u*)(op + 8 * g) = a;
        v2u c2; c2.x = pk_bf16(o1[4 * g], o1[4 * g + 1]); c2.y = pk_bf16(o1[4 * g + 2], o1[4 * g + 3]); *(v2u*)(op + 32 + 8 * g) = c2;
    }
}
__device__ __forceinline__ void conv_item(const bf16* __restrict__ PROJ, const float* __restrict__ wconv, bf16* __restrict__ CM, int it) {
    const int cgp = it & 63, run = it >> 6, c0 = cgp * 8; const int t_start = run * 16; const bool first = (t_start % SEQ) == 0;
    f32x4 w0a = *(const f32x4*)(wconv + c0), w0b = *(const f32x4*)(wconv + c0 + 4), w1a = *(const f32x4*)(wconv + AW + c0), w1b = *(const f32x4*)(wconv + AW + c0 + 4),
          w2a = *(const f32x4*)(wconv + 2 * AW + c0), w2b = *(const f32x4*)(wconv + 2 * AW + c0 + 4);
    f32x4 m2a = {0.f, 0.f, 0.f, 0.f}, m2b = m2a, m1a = m2a, m1b = m2a;
    if (!first) {
        pg8::unpack8(*(const v4u*)(PROJ + (size_t)(t_start - 2) * DIN + C_CC + c0), m2a, m2b);
        pg8::unpack8(*(const v4u*)(PROJ + (size_t)(t_start - 1) * DIN + C_CC + c0), m1a, m1b);
    }
#pragma unroll 4
    for (int t = 0; t < 16; ++t) {
        const bf16* rowp = PROJ + (size_t)(t_start + t) * DIN + c0;
        f32x4 ma, mb, g0, g1;
        pg8::unpack8(*(const v4u*)(rowp + C_CC), ma, mb); pg8::unpack8(*(const v4u*)(rowp + C_CB), g0, g1);
        const f32x4 ra = g0 * (w0a * m2a + w1a * m1a + w2a * ma), rb = g1 * (w0b * m2b + w1b * m1b + w2b * mb);
        *(v4u*)(CM + (size_t)(t_start + t) * D + c0) = pg8::pack8(ra, rb);
        m2a = m1a; m2b = m1b; m1a = ma; m1b = mb;
    }
}

struct Args { const float* in[17]; float* out; unsigned char* ws; int ph_lo, ph_hi; };
__global__ void __launch_bounds__(NWAVES * 64, 2) fwd_megakernel(Args args) {
    extern __shared__ __attribute__((aligned(16))) unsigned char lds_raw[];
    LAS unsigned char* lds = (LAS unsigned char*)lds_raw;
    cg::grid_group grid = cg::this_grid();
    const int tid = threadIdx.x, lane = tid & 63, wave = __builtin_amdgcn_readfirstlane(tid >> 6);
    const int G = gridDim.x, bx = blockIdx.x;
    const int gw = bx * NWAVES + wave, NGW = G * NWAVES;
    unsigned char* ws = args.ws;
#define xin ((const float*)args.in[0])
#define pin ((const float*)args.in[1])
#define g_pre_mix ((const float*)args.in[2])
#define w_in ((const float*)args.in[3])
#define b_gate ((const float*)args.in[4])
#define w_conv ((const float*)args.in[5])
#define w_attn_out ((const float*)args.in[6])
#define w_conv_out ((const float*)args.in[7])
#define w_o ((const float*)args.in[8])
#define g_post_mix ((const float*)args.in[9])
#define g_pre_mlp ((const float*)args.in[10])
#define w_up ((const float*)args.in[11])
#define w_down ((const float*)args.in[12])
#define g_post_mlp ((const float*)args.in[13])
#define g_ple ((const float*)args.in[14])
#define w_ple_gate ((const float*)args.in[15])
#define w_ple_proj ((const float*)args.in[16])
    float* out = args.out;
    bf16* Win_t = (bf16*)(ws + WS_WIN); bf16* Wa_t = (bf16*)(ws + WS_WA); bf16* Wc_t = (bf16*)(ws + WS_WC); bf16* Wo_t = (bf16*)(ws + WS_WO);
    bf16* Wup_t = (bf16*)(ws + WS_WUP); bf16* Wdn_t = (bf16*)(ws + WS_WDN); bf16* Wpg_t = (bf16*)(ws + WS_WPG); bf16* Wpp_t = (bf16*)(ws + WS_WPP);
    bf16* R1 = (bf16*)(ws + WS_R1); bf16* R2 = (bf16*)(ws + WS_R2); bf16* R3 = (bf16*)(ws + WS_R3); bf16* PB = (bf16*)(ws + WS_PB);
    bf16* XN = R1; bf16* MB = R1; bf16* PPB = R1;
    bf16* OB = R2; bf16* CM = R2 + AW; bf16* XB = R2;
    float* SS2 = (float*)(ws + WS_SS2); float* SS3 = (float*)(ws + WS_SS3);
    bf16* PROJ = R3; bf16* HB = R3;
    const int lo = args.ph_lo, hi = args.ph_hi;
    volatile LAS unsigned* bst = (volatile LAS unsigned*)(lds + RING_BYTES + 384);
    if (tid < 2) bst[tid] = 0u;
    __syncthreads();
    if (lo < 0) grid.sync();
    XcdBarrier bar; bar.bar = (unsigned*)ws; bar.x = 0; bar.st = bst;
    if (hi - lo > 1) bar = xcd_barrier_post((unsigned*)ws, bst);
#ifndef PROBE_DUP_MASK
#define PROBE_DUP_MASK 0
#endif
#ifndef PROBE_P9_MODE
#define PROBE_P9_MODE 1
#endif
#ifndef PROBE_DUP_SYNC
#define PROBE_DUP_SYNC 0
#endif
#define IN(k) (lo <= (k) && (k) < hi)
#define REP(k) for (int rep_ = 0; rep_ < (((PROBE_DUP_MASK >> (k)) & 1) ? 2 : 1); ++rep_)
#ifndef STAG_US
#define STAG_US 0
#endif
#define STAGGER() do { const unsigned sg_ = ((unsigned)bx >> 3) & 3u; if (STAG_US && sg_) { const unsigned long long t0_ = __builtin_amdgcn_s_memrealtime(); while (__builtin_amdgcn_s_memrealtime() - t0_ < (unsigned long long)(sg_ * STAG_US * 10u)) __builtin_amdgcn_s_sleep(8); } } while (0)
#define STAGGER2(tenths) do { if ((tenths) && (((unsigned)bx >> 3) & 1u)) { const unsigned long long t0_ = __builtin_amdgcn_s_memrealtime(); while (__builtin_amdgcn_s_memrealtime() - t0_ < (unsigned long long)((tenths) * 10u)) __builtin_amdgcn_s_sleep(8); } } while (0)
#ifndef STAG_P3
#define STAG_P3 0
#endif
#ifndef STAG_P4
#define STAG_P4 0
#endif
#ifndef STAG_P7
#define STAG_P7 0
#endif
#ifndef STAG_P9
#define STAG_P9 0
#endif
#define SEAM(k) do { if (IN(k) && IN((k) + 1)) { xcd_barrier(bar); if (PROBE_DUP_SYNC) xcd_barrier(bar); } } while (0)

    constexpr int I_IN = (D / 64) * (DIN / 32), I_A = (AW / 64) * (D / 32), I_O = (D / 64) * (D / 32), I_UP = (D / 64) * (FF / 32), I_DN = (FF / 64) * (D / 32), I_PP = (PLE / 64) * (D / 32);
    if (IN(0)) REP(0) {
        LAS float* scr = (LAS float*)(lds + wave * 16384);
        for (int it = gw; it < I_IN; it += NGW) p0_transpose_item(w_in, D, DIN, Win_t, scr, it, lane, nullptr, 0, true);
        for (int m = gw; m < M; m += NGW) rms_row_to_bf16(xin + (size_t)m * D, g_pre_mix, XN + (size_t)m * D, lane);
        __syncthreads();
    }
    SEAM(0);
    if (IN(1)) REP(1) {
        STAGGER();
        pg8::Gemm g{XN, Win_t, M, DIN, D}; pg8::StaticOrder S; S.init(M, DIN, G, bx);
        pg8::EpiTile8<pg8::FProj> E{{PROJ, b_gate}};
        pg8::gemm_phase<pg8::EpiTile8<pg8::FProj>, pg8::StaticOrder, true, true>(lds, g, S, E);
    }
    SEAM(1);
    if (IN(2)) REP(2) {
        constexpr int NQT = SEQ / 32, NUNITS = BATCH * NH * NQT;
        for (int pass = 0; pass < 2; ++pass) {
            if ((pass ^ wave) & 1) {
                LAS float* scr = (LAS float*)(lds + wave * 16384);
                constexpr int NITEMS = 2 * I_A + 2 * I_O + I_UP + I_DN + I_PP;
                for (int it = gw; it < NITEMS; it += NGW) {
                    int r = it; const float* W; int K_, N_; bf16* WT; const float* gain = nullptr; int ldw = 0;
                    if (r < I_A) { W = w_attn_out; K_ = AW; N_ = D; WT = Wa_t; ldw = D; }
                    else if ((r -= I_A) < I_A) { W = w_conv_out; K_ = AW; N_ = D; WT = Wa_t + AW; ldw = D; }
                    else if ((r -= I_A) < I_O) { W = w_o; K_ = D; N_ = D; WT = Wo_t; }
                    else if ((r -= I_O) < I_UP) { W = w_up; K_ = D; N_ = FF; WT = Wup_t; gain = g_pre_mlp; }
                    else if ((r -= I_UP) < I_DN) { W = w_down; K_ = FF; N_ = D; WT = Wdn_t; }
                    else if ((r -= I_DN) < I_O) { W = w_ple_gate; K_ = D; N_ = D; WT = Wpg_t; gain = g_ple; ldw = D + PLE; }
                    else { r -= I_O; W = w_ple_proj; K_ = PLE; N_ = D; WT = Wpg_t + D; ldw = D + PLE; }
                    p0_transpose_item(W, K_, N_, WT, scr, r, lane, gain, ldw);
                }
                for (int it = gw * 64 + lane; it < (M / 16) * 64; it += NGW * 64) conv_item(PROJ, w_conv, CM, it);
                for (int i = gw * 64 + lane; i < M * PLE / 8; i += NGW * 64) {
                    const f32x4 a = *(const f32x4*)(pin + (size_t)i * 8), b2 = *(const f32x4*)(pin + (size_t)i * 8 + 4);
                    *(v4u*)(PB + (size_t)i * 8) = pg8::pack8(a, b2);
                }
            } else {
                for (int u = gw; u < NUNITS; u += NGW) { const int qt = u % NQT, bh = u / NQT; attn_unit(PROJ, OB, bh / NH, bh % NH, qt, lane); }
            }
        }
        __syncthreads();
    }
    SEAM(2);
    if (IN(3)) REP(3) {
        pg8::Gemm g{OB, Wa_t, M, D, D}; pg8::StaticOrder S; S.init(M, D, G, bx);
        pg8::EpiTile8<pg8::FMix> E{{MB, PROJ + C_GA, PROJ + C_GC}};
        pg8::gemm_phase<pg8::EpiTile8<pg8::FMix>, pg8::StaticOrder, true, true>(lds, g, S, E);
    }
    SEAM(3);
    if (IN(4)) REP(4) {
        STAGGER2(STAG_P4);
        pg8::Gemm g{MB, Wo_t, M, D, D}; pg8::StaticOrder S; S.init(M, D, G, bx);
        pg8::PanelRms s1{(unsigned*)(ws + WS_XB), (unsigned*)(ws + WS_CNT), EPS};
        pg8::EpiRmsRes<false> E{xin, XB, g_post_mix, SS2, s1, lds + RING_BYTES + 1024};
        pg8::gemm_phase<pg8::EpiRmsRes<false>, pg8::StaticOrder, true, true>(lds, g, S, E);
    }
    SEAM(4);
    if (IN(6)) REP(6) {
        pg8::Gemm g{XB, Wup_t, M, FF, D}; pg8::StaticOrder S; S.init(M, FF, G, bx);
        pg8::EpiTile8<pg8::FStoreRt> E{{HB, FF, 1, SS2, EPS, lds + RING_BYTES + 1024 + 4096, -1}};
        pg8::gemm_phase<pg8::EpiTile8<pg8::FStoreRt>, pg8::StaticOrder, true, true>(lds, g, S, E);
    }
    SEAM(6);
    if (IN(7)) REP(7) {
        STAGGER2(STAG_P7);
        pg8::Gemm g{HB, Wdn_t, M, D, FF}; pg8::StaticOrder S; S.init(M, D, G, bx);
        pg8::PanelRms s1{(unsigned*)(ws + WS_XB + 512 * 1024), (unsigned*)(ws + WS_CNT + 32768), EPS};
        pg8::EpiRmsRes<true> E{XB, XB, g_post_mlp, SS3, s1, lds + RING_BYTES + 1024};
        pg8::gemm_phase<pg8::EpiRmsRes<true>, pg8::StaticOrder, true, true>(lds, g, S, E);
    }
    SEAM(7);
    if (IN(9)) REP(9) {
        pg8::Gemm2 g{XB, PB, Wpg_t, M, D, D + PLE, D, PLE, D / 64}; pg8::StaticOrder S; S.init(M, D, G, bx);
        LAS float* rtab = (LAS float*)(lds + RING_BYTES + 1024 + 4096);
        pg8::Unit u0{0, 0}, u1{0, 0}, u2{0, 0}; const bool h0 = S.next(0, u0), h1 = S.next(1, u1), h2 = S.next(2, u2);
        const int use_tab = (h0 && !h2) ? 1 : 0;
        if (use_tab) { const int t = threadIdx.x & 255, w = threadIdx.x >> 8;
            if (w == 0 || h1) rtab[w * 256 + t] = pg8::rstd16(SS3, (w ? u1.pm : u0.pm) * 256 + t, EPS); }
        __syncthreads();
        pg8::EpiTile8<pg8::FFinal> E{{XB, out, PPB, SS3, EPS, rtab, u0.pm, use_tab}};
        pg8::gemm_phase_split<pg8::EpiTile8<pg8::FFinal>, pg8::StaticOrder, true, true>(lds, g, S, E);
    }
#undef IN
#undef SEAM
#undef xin
#undef pin
#undef g_pre_mix
#undef w_in
#undef b_gate
#undef w_conv
#undef w_attn_out
#undef w_conv_out
#undef w_o
#undef g_post_mix
#undef g_pre_mlp
#undef w_up
#undef w_down
#undef g_post_mlp
#undef g_ple
#undef w_ple_gate
#undef w_ple_proj
}

#ifndef MK_N_LAUNCHES
#define MK_N_LAUNCHES 1
#endif
constexpr int N_PHASES = 10;
extern "C" void kernel_launch(void* const* d_in, const int* in_sizes, int n_in, void* d_out, int out_size, void* d_ws, size_t ws_size, hipStream_t stream) {
    static int grid = 0;
    if (grid == 0) {
        if (n_in != 17 || in_sizes[0] != M * D || out_size != M * D || ws_size < WS_END) { fprintf(stderr, "kernel_launch: unexpected shapes (n_in %d, in0 %d, out %d, ws %zu)\n", n_in, n_in > 0 ? in_sizes[0] : -1, out_size, ws_size); grid = -1; return; }
        int dev = 0, cus = 0, per_cu = 0;
        hipGetDevice(&dev); hipDeviceGetAttribute(&cus, hipDeviceAttributeMultiprocessorCount, dev);
        if (hipFuncSetAttribute((const void*)fwd_megakernel, hipFuncAttributeMaxDynamicSharedMemorySize, LDS_BYTES) != hipSuccess) { fprintf(stderr, "kernel_launch: hipFuncSetAttribute failed\n"); grid = -1; return; }
        if (hipOccupancyMaxActiveBlocksPerMultiprocessor(&per_cu, (const void*)fwd_megakernel, NWAVES * 64, LDS_BYTES) != hipSuccess || per_cu < 1) { fprintf(stderr, "kernel_launch: occupancy query says %d\n", per_cu); per_cu = 1; }
        (void)hipGetLastError();
        grid = cus * per_cu;
        fprintf(stderr, "kernel_launch: grid %d (cus %d x %d)\n", grid, cus, per_cu);
    }
    if (grid < 0) return;
    Args a{};
    for (int i = 0; i < 17; ++i) a.in[i] = (const float*)d_in[i];
    a.out = (float*)d_out; a.ws = (unsigned char*)d_ws;
#if MK_N_LAUNCHES == 1
    a.ph_lo = 0; a.ph_hi = N_PHASES;
    if (hipMemsetAsync(d_ws, 0, 262144, stream) != hipSuccess) { fprintf(stderr, "kernel_launch: memset failed\n"); return; }
    void* kargs[] = {&a};
    hipError_t e = hipLaunchCooperativeKernel((const void*)fwd_megakernel, dim3(grid), dim3(NWAVES * 64), kargs, LDS_BYTES, stream);
    if (e != hipSuccess) fprintf(stderr, "cooperative launch failed: %s (grid %d)\n", hipGetErrorString(e), grid);
#else
    for (int ph = 0; ph < N_PHASES; ++ph) { a.ph_lo = ph; a.ph_hi = ph + 1; hipLaunchKernelGGL(fwd_megakernel, dim3(grid), dim3(NWAVES * 64), LDS_BYTES, stream, a); }
#endif
}
```

```cpp
#include <hip/hip_runtime.h>
#include <hip/hip_cooperative_groups.h>
#include <cstdio>
#include <cstdint>
namespace cg = cooperative_groups;
namespace pg8 {
#define PG8_LAS __attribute__((address_space(3)))
typedef unsigned short bf16_t;
typedef short bf16x8 __attribute__((ext_vector_type(8)));
typedef float f32x4 __attribute__((ext_vector_type(4)));
typedef unsigned u32x4 __attribute__((ext_vector_type(4)));
constexpr int BM = 256, BK = 64, HALF = 128, HTB = HALF * BK * 2  , STAGE_BYTES = 8 * HTB, NXCD = 8, WGM = 8;

__host__ __device__ __forceinline__ int lds_byte(int r, int c) { const int st = (r >> 4) * 2 + (c >> 5), rr = r & 15, cc = c & 31, ob = rr * 64 + cc * 2; return st * 1024 + (ob ^ (((ob >> 9) & 1) << 5)); }
__host__ __device__ __forceinline__ void stage_rc(int b, int& R, int& C) { const int st = b / 1024, sb = b % 1024, swz = sb ^ (((sb >> 9) & 1) << 5); R = (st >> 1) * 16 + swz / 64; C = (st & 1) * 32 + (swz % 64) / 2; }
__host__ __device__ __forceinline__ int perm32(int rho) { const int n = rho >> 4, i = rho & 15; return 8 * (i >> 2) + 4 * n + (i & 3); }

struct Unit { int pm, pn; };
struct Gemm { const bf16_t* A; const bf16_t* Bt; int M, N, K; };

struct StaticOrder {
    int nM, nN, nwg, G, c;
    __host__ __device__ void init(int M, int N, int G_, int c_) { nM = M / BM; nN = N / BM; nwg = nM * nN; G = G_; c = c_; }
    __host__ __device__ bool next(int i, Unit& u) const {
        const long L = (long)i * G + c; if (L >= nwg) return false;
        int wgid = (int)L; { const int q = nwg / NXCD, r = nwg % NXCD, xcd = wgid % NXCD, off = wgid / NXCD; wgid = (xcd < r ? xcd * (q + 1) : r * (q + 1) + (xcd - r) * q) + off; }
        const int nig = WGM * nN, gid = wgid / nig, fm = gid * WGM, gsz = (nM - fm) < WGM ? (nM - fm) : WGM;
        u.pm = fm + ((wgid % nig) % gsz); u.pn = (wgid % nig) / gsz; return true;
    }
    __device__ __forceinline__ void a_ready(const Unit&) const {}
    __device__ __forceinline__ void done(const Unit&) const {}
};

__device__ __forceinline__ unsigned cvt_pk_bf16(float lo, float hi) { unsigned r; asm volatile("v_cvt_pk_bf16_f32 %0, %1, %2" : "=v"(r) : "v"(lo), "v"(hi)); return r; }
typedef float f32x2 __attribute__((ext_vector_type(2)));
typedef __bf16 bf16x2_t __attribute__((ext_vector_type(2)));
__device__ __forceinline__ unsigned pk_bf16(float lo, float hi) { f32x2 v = {lo, hi}; bf16x2_t b = __builtin_convertvector(v, bf16x2_t); return __builtin_bit_cast(unsigned, b); }
__device__ __forceinline__ float bf_lo(unsigned w) { return __uint_as_float(w << 16); }
__device__ __forceinline__ float bf_hi(unsigned w) { return __uint_as_float(w & 0xffff0000u); }
__device__ __forceinline__ float sigmoidf_fast(float x) { return __builtin_amdgcn_rcpf(1.0f + __builtin_amdgcn_exp2f(-1.4426950408889634f * x)); }
__device__ __forceinline__ u32x4 pack8(const f32x4 a, const f32x4 b) { u32x4 w; w.x = pk_bf16(a[0], a[1]); w.y = pk_bf16(a[2], a[3]); w.z = pk_bf16(b[0], b[1]); w.w = pk_bf16(b[2], b[3]); return w; }
__device__ __forceinline__ void unpack8(const u32x4 w, f32x4& a, f32x4& b) { a = (f32x4){bf_lo(w.x), bf_hi(w.x), bf_lo(w.y), bf_hi(w.y)}; b = (f32x4){bf_lo(w.z), bf_hi(w.z), bf_lo(w.w), bf_hi(w.w)}; }

template <class F> struct EpiTile8 {
    static constexpr bool PERM = true, AFTER_DRAIN = false, MIDHOOK = F::MIDHOOK;
    F f;
    __device__ __forceinline__ void mid(f32x4 (&acc)[2][2][4][2], const Unit& u, int wr, int wc, int fr, int fq) const {
        if constexpr (F::MIDHOOK) {
            int row0 = u.pm * BM + wr * 64 + fr, col0 = u.pn * BM + wc * 32 + 8 * fq;
            asm volatile("" : "+v"(row0), "+v"(col0));
            float rsv[2][4];
#pragma unroll
            for (int ai = 0; ai < 2; ++ai) {
#pragma unroll
                for (int m = 0; m < 4; ++m) { rsv[ai][m] = 1.f; if constexpr (F::ROWSCALE) rsv[ai][m] = f.rowscale(row0 + ai * HALF + m * 16); }
                if constexpr (F::ROWSCALE) asm volatile("" ::: "memory");
            }
#pragma unroll
            for (int ai = 0; ai < 2; ++ai)
#pragma unroll
                for (int m = 0; m < 4; ++m) {
#pragma unroll
                    for (int bj = 0; bj < 2; ++bj) { f.mid(row0 + ai * HALF + m * 16, col0 + bj * HALF, acc[ai][bj][m][0], acc[ai][bj][m][1], rsv[ai][m]); asm volatile("" ::: "memory"); }
                }
        }
    }
    __device__ __forceinline__ void operator()(const f32x4 (&acc)[2][2][4][2], const Unit& u, int wr, int wc, int fr, int fq) const {
        const int row0 = u.pm * BM + wr * 64 + fr, col0 = u.pn * BM + wc * 32 + 8 * fq;
        float rsv[2][4];
        if constexpr (F::ROWTABLE) {
            PG8_LAS float* S = (PG8_LAS float*)f.tb;
            if (u.pm != f.cached_pm) {
                const int t = (wr * 4 + wc) * 64 + fq * 16 + fr;
                if (t < 256) S[t] = f.rowscale(u.pm * BM + t);
                asm volatile("s_waitcnt lgkmcnt(0)" ::: "memory"); __builtin_amdgcn_s_barrier(); asm volatile("" ::: "memory");
                f.cached_pm = u.pm;
            }
#pragma unroll
            for (int ai = 0; ai < 2; ++ai)
#pragma unroll
                for (int m = 0; m < 4; ++m) rsv[ai][m] = S[ai * HALF + wr * 64 + m * 16 + fr];
        } else {
#pragma unroll
        for (int ai = 0; ai < 2; ++ai) {
#pragma unroll
            for (int m = 0; m < 4; ++m) { rsv[ai][m] = 1.f; if constexpr (F::ROWSCALE && !F::MIDHOOK) rsv[ai][m] = f.rowscale(row0 + ai * HALF + m * 16); }
            if constexpr (F::ROWSCALE && !F::MIDHOOK) asm volatile("" ::: "memory");
        }
        }
#pragma unroll
        for (int ai = 0; ai < 2; ++ai)
#pragma unroll
            for (int m = 0; m < 4; ++m) {
                const int row = row0 + ai * HALF + m * 16;
                const float rs = rsv[ai][m];
                if constexpr (F::PAIR) f.pair(row, col0, u.pn, acc[ai][0][m][0], acc[ai][0][m][1], acc[ai][1][m][0], acc[ai][1][m][1]);
                else {
#pragma unroll
                for (int bj = 0; bj < 2; ++bj) f(row, col0 + bj * HALF, u.pn, acc[ai][bj][m][0], acc[ai][bj][m][1], rs);
                }
                if (F::FENCE && (m & 1)) asm volatile("" ::: "memory");
            }
    }
};
__device__ __forceinline__ float rstd16(const float* ssp, int row, float eps) {
    const f32x4* q = (const f32x4*)(ssp + (size_t)row * 16); const f32x4 a = q[0], b = q[1], c = q[2], d = q[3];
    const float t = (((a[0] + a[1]) + (a[2] + a[3])) + ((b[0] + b[1]) + (b[2] + b[3]))) + (((c[0] + c[1]) + (c[2] + c[3])) + ((d[0] + d[1]) + (d[2] + d[3])));
    return 1.0f / sqrtf(t * (1.0f / 1024.0f) + eps);
}
struct FProj { static constexpr bool FENCE = false, ROWSCALE = false, MIDHOOK = false, PAIR = true, ROWTABLE = false; bf16_t* O; const float* bgate;
    __device__ __forceinline__ void pair(int row, int col0, int pn, f32x4 a0, f32x4 a1, f32x4 b0, f32x4 b1) const {
        bf16_t* rowp = O + (size_t)row * 5120;
        if (pn < 8) { *(u32x4*)(rowp + col0) = pack8(a0, a1); *(u32x4*)(rowp + col0 + HALF) = pack8(b0, b1); }
        else { const int c = (col0 & 127) + ((pn - 8) & 3) * 128 + (pn >= 12 ? (pn - 12) / 4 * 512 : 0);
            if (pn < 12) *(u32x4*)(rowp + 2048 + c) = pack8(a0 * b0, a1 * b1);
            else { const f32x4 ba0 = *(const f32x4*)(bgate + c), ba1 = *(const f32x4*)(bgate + c + 4), bc0 = *(const f32x4*)(bgate + 1024 + c), bc1 = *(const f32x4*)(bgate + 1024 + c + 4);
#pragma unroll
                for (int i = 0; i < 4; ++i) {
                    const float dc0 = 1.0f + fminf(__builtin_amdgcn_exp2f(-1.4426950408889634f * (b0[i] + bc0[i])), 1e30f), dc1 = 1.0f + fminf(__builtin_amdgcn_exp2f(-1.4426950408889634f * (b1[i] + bc1[i])), 1e30f);
                    const float da0 = 1.0f + __builtin_amdgcn_exp2f(-1.4426950408889634f * (a0[i] + ba0[i])), da1 = 1.0f + __builtin_amdgcn_exp2f(-1.4426950408889634f * (a1[i] + ba1[i]));
                    a0[i] = dc0 * __builtin_amdgcn_rcpf(da0); a1[i] = dc1 * __builtin_amdgcn_rcpf(da1); b0[i] = __builtin_amdgcn_rcpf(dc0); b1[i] = __builtin_amdgcn_rcpf(dc1); }
                *(u32x4*)(rowp + 3072 + c) = pack8(a0, a1); *(u32x4*)(rowp + 4096 + c) = pack8(b0, b1); } } }
    __device__ __forceinline__ void operator()(int, int, int, f32x4, f32x4, float) const {} };
struct FMix { static constexpr bool FENCE = true, ROWSCALE = false, MIDHOOK = true, PAIR = false, ROWTABLE = false; bf16_t* MB; const bf16_t* GA; const bf16_t* GC;
    __device__ __forceinline__ void mid(int row, int col, f32x4& v0, f32x4& v1, float) const {
        f32x4 a0, a1; unpack8(*(const u32x4*)(GA + (size_t)row * 5120 + col), a0, a1); v0 = v0 * a0; v1 = v1 * a1; }
    __device__ __forceinline__ void operator()(int row, int col, int, f32x4 v0, f32x4 v1, float) const {
        f32x4 c0, c1; unpack8(*(const u32x4*)(GC + (size_t)row * 5120 + col), c0, c1);
#pragma unroll
        for (int i = 0; i < 4; ++i) { v0[i] *= fmaxf(c0[i], 1e-30f); v1[i] *= fmaxf(c1[i], 1e-30f); }
        *(u32x4*)(MB + (size_t)row * 1024 + col) = pack8(v0, v1); } };
template <int ACT  > struct FStore { static constexpr bool FENCE = false, ROWSCALE = false, MIDHOOK = false, PAIR = false, ROWTABLE = false; bf16_t* O; int ldc;
    __device__ __forceinline__ void operator()(int row, int col, int, f32x4 v0, f32x4 v1, float) const {
        if (ACT == 1) {
#pragma unroll
            for (int i = 0; i < 4; ++i) { const float a = fmaxf(v0[i], 0.f), b = fmaxf(v1[i], 0.f); v0[i] = a * a; v1[i] = b * b; } }
        if (ACT == 2) {
#pragma unroll
            for (int i = 0; i < 4; ++i) { v0[i] = sigmoidf_fast(v0[i]); v1[i] = sigmoidf_fast(v1[i]); } }
        *(u32x4*)(O + (size_t)row * ldc + col) = pack8(v0, v1); } };
struct FStoreRt { static constexpr bool FENCE = false, ROWSCALE = true, MIDHOOK = false, PAIR = false, ROWTABLE = true; bf16_t* O; int ldc; int act; const float* ssp; float eps; PG8_LAS unsigned char* tb; mutable int cached_pm;
    __device__ __forceinline__ float rowscale(int row) const { return act == 1 ? rstd16(ssp, row, eps) : 1.f; }
    __device__ __forceinline__ void operator()(int row, int col, int, f32x4 v0, f32x4 v1, float rs) const {
        if (act == 1) {
#pragma unroll
            for (int i = 0; i < 4; ++i) { const float a = fmaxf(v0[i] * rs, 0.f), b = fmaxf(v1[i] * rs, 0.f); v0[i] = a * a; v1[i] = b * b; } }
        *(u32x4*)(O + (size_t)row * ldc + col) = pack8(v0, v1); } };
struct FFinal { static constexpr bool FENCE = true, ROWSCALE = true, MIDHOOK = true, PAIR = false, ROWTABLE = false; const bf16_t* X2; float* out; bf16_t* GB; const float* ssp; float eps; const PG8_LAS float* tab; int pm0, use_tab;
    __device__ __forceinline__ float rowscale(int row) const { return use_tab ? tab[(((row >> 8) == pm0) ? 0 : 256) + (row & 255)] : rstd16(ssp, row, eps); }
    __device__ __forceinline__ void mid(int row, int col, f32x4& v0, f32x4& v1, float rs) const {
#pragma unroll
        for (int i = 0; i < 4; ++i) { v0[i] = sigmoidf_fast(v0[i] * rs); v1[i] = sigmoidf_fast(v1[i] * rs); }
        *(u32x4*)(GB + (size_t)row * 1024 + col) = pack8(v0, v1);
        v0 = (f32x4){0.f, 0.f, 0.f, 0.f}; v1 = v0; }
    __device__ __forceinline__ void operator()(int row, int col, int, f32x4 v0, f32x4 v1, float) const {
        f32x4 g0, g1, x0, x1; unpack8(*(const u32x4*)(GB + (size_t)row * 1024 + col), g0, g1); unpack8(*(const u32x4*)(X2 + (size_t)row * 1024 + col), x0, x1);
        float* p = out + (size_t)row * 1024 + col;
        *(f32x4*)p = x0 + g0 * v0; *(f32x4*)(p + 4) = x1 + g1 * v1; } };

struct PanelRms {
    unsigned* xbuf;
    unsigned* cnt;
    float eps;
    __device__ __forceinline__ void run(const f32x4 (&v)[2][2][4][2], const Unit& u, int wr, int wc, int fr, int fq, PG8_LAS unsigned char* tb, int wid, int lane) const {
        PG8_LAS float* P = (PG8_LAS float*)tb;
        PG8_LAS float* S = (PG8_LAS float*)(tb + 4096);
#pragma unroll
        for (int ai = 0; ai < 2; ++ai)
#pragma unroll
            for (int m = 0; m < 4; ++m) {
                float s = 0.f;
#pragma unroll
                for (int bj = 0; bj < 2; ++bj)
#pragma unroll
                    for (int n = 0; n < 2; ++n) { const f32x4 x = v[ai][bj][m][n]; s += (x[0] * x[0] + x[1] * x[1]) + (x[2] * x[2] + x[3] * x[3]); }
                s += __shfl_xor(s, 16); s += __shfl_xor(s, 32);
                if (fq == 0) P[(ai * HALF + wr * 64 + m * 16 + fr) * 4 + wc] = s;
            }
        asm volatile("s_waitcnt lgkmcnt(0)" ::: "memory"); __builtin_amdgcn_s_barrier(); asm volatile("" ::: "memory");
        const int row = wid * 32 + (lane & 31);
        if (lane < 32) {
            const f32x4 a = *(const PG8_LAS f32x4*)(P + row * 4);
            __hip_atomic_store(xbuf + ((size_t)(u.pm * BM + row) * 4 + u.pn), __float_as_uint((a[0] + a[1]) + (a[2] + a[3])), __ATOMIC_RELAXED, __HIP_MEMORY_SCOPE_AGENT);
        }
        asm volatile("s_waitcnt vmcnt(0)" ::: "memory");
        if (lane == 0) __hip_atomic_fetch_add(cnt + 64 * u.pm, 1u, __ATOMIC_RELAXED, __HIP_MEMORY_SCOPE_AGENT);
        if (wid == 0) {
            unsigned sp = 0;
            while ((unsigned)__builtin_amdgcn_readfirstlane(__hip_atomic_load(cnt + 64 * u.pm, __ATOMIC_RELAXED, __HIP_MEMORY_SCOPE_AGENT)) < 32u) { __builtin_amdgcn_s_sleep(2); if (++sp > (1u << 22)) break; }
            __builtin_amdgcn_fence(__ATOMIC_ACQUIRE, "agent");
        }
        asm volatile("s_waitcnt vmcnt(0) lgkmcnt(0)" ::: "memory"); __builtin_amdgcn_s_barrier(); asm volatile("" ::: "memory");
        if (lane < 32) {
            const unsigned* slot = xbuf + (size_t)(u.pm * BM + row) * 4; float t = 0.f;
#pragma unroll
            for (int k = 0; k < 4; ++k) t += __uint_as_float(__hip_atomic_load(slot + k, __ATOMIC_RELAXED, __HIP_MEMORY_SCOPE_AGENT));
            S[row] = 1.0f / sqrtf(t * (1.0f / 1024.0f) + eps);
        }
        asm volatile("s_waitcnt lgkmcnt(0)" ::: "memory"); __builtin_amdgcn_s_barrier(); asm volatile("" ::: "memory");
    }
};
template <bool BASE_BF16> struct EpiRmsRes {
    static constexpr bool PERM = true, AFTER_DRAIN = false, MIDHOOK = false, PAIR = false, ROWTABLE = false;
    const void* base; bf16_t* xb; const float* g1; float* ssp; PanelRms st; PG8_LAS unsigned char* tb;
    __device__ __forceinline__ void operator()(f32x4 (&acc)[2][2][4][2], const Unit& u, int wr, int wc, int fr, int fq) const {
        const int wid = wr * 4 + wc, lane = fq * 16 + fr;
        const PG8_LAS float* S = (const PG8_LAS float*)(tb + 4096);
        const int col0 = u.pn * BM + wc * 32 + 8 * fq;
        u32x4 preb[4][2]; f32x4 pref[2][2][2];
        if (BASE_BF16) {
#pragma unroll
            for (int m = 0; m < 4; ++m)
#pragma unroll
                for (int bj = 0; bj < 2; ++bj) preb[m][bj] = *(const u32x4*)((const bf16_t*)base + (size_t)(u.pm * BM + wr * 64 + m * 16 + fr) * 1024 + col0 + bj * HALF);
        } else {
#pragma unroll
            for (int m = 0; m < 2; ++m)
#pragma unroll
                for (int bj = 0; bj < 2; ++bj) { const float* bp = (const float*)base + (size_t)(u.pm * BM + wr * 64 + m * 16 + fr) * 1024 + col0 + bj * HALF; pref[m][bj][0] = *(const f32x4*)bp; pref[m][bj][1] = *(const f32x4*)(bp + 4); }
        }
        st.run(acc, u, wr, wc, fr, fq, tb, wid, lane);
        f32x4 gv[2][2];
#pragma unroll
        for (int bj = 0; bj < 2; ++bj) { gv[bj][0] = *(const f32x4*)(g1 + col0 + bj * HALF); gv[bj][1] = *(const f32x4*)(g1 + col0 + bj * HALF + 4); }
#pragma unroll
        for (int ai = 0; ai < 2; ++ai)
#pragma unroll
            for (int m = 0; m < 4; ++m) { const int r = ai * HALF + wr * 64 + m * 16 + fr; const float rs = S[r]; const size_t off = (size_t)(u.pm * BM + r) * 1024 + col0; float s = 0.f;
#pragma unroll
                for (int bj = 0; bj < 2; ++bj) { f32x4 b0, b1;
                    if (BASE_BF16 && ai == 0) unpack8(preb[m][bj], b0, b1);
                    else if (BASE_BF16) unpack8(*(const u32x4*)((const bf16_t*)base + off + bj * HALF), b0, b1);
                    else if (ai == 0 && m < 2) { b0 = pref[m][bj][0]; b1 = pref[m][bj][1]; }
                    else { b0 = *(const f32x4*)((const float*)base + off + bj * HALF); b1 = *(const f32x4*)((const float*)base + off + bj * HALF + 4); }
                    const f32x4 a = b0 + acc[ai][bj][m][0] * rs * gv[bj][0], b = b1 + acc[ai][bj][m][1] * rs * gv[bj][1];
                    s += ((a[0] * a[0] + a[1] * a[1]) + (a[2] * a[2] + a[3] * a[3])) + ((b[0] * b[0] + b[1] * b[1]) + (b[2] * b[2] + b[3] * b[3]));
                    *(u32x4*)(xb + off + bj * HALF) = pack8(a, b); }
                s += __shfl_xor(s, 16); s += __shfl_xor(s, 32);
                if (fq == 0) ssp[(size_t)(u.pm * BM + r) * 16 + u.pn * 4 + wc] = s;
                if (m & 1) asm volatile("" ::: "memory"); }
    }
};

template <class Epi, class Sched, bool ALIGN_EPI = false, bool SP2 = false>
__device__ __forceinline__ void gemm_phase(PG8_LAS unsigned char* lds, const Gemm g, const Sched& S, const Epi& E) {
    int tid_ = threadIdx.x; asm volatile("" : "+v"(tid_));
    const int tid = tid_, wid = __builtin_amdgcn_readfirstlane(tid >> 6), lane = tid & 63, wr = wid >> 2, wc = wid & 3, fr = lane & 15, fq = lane >> 4;
    const int K = g.K, nt = K / BK;
    unsigned voffA[2], voffB[2];
#pragma unroll
    for (int i = 0; i < 2; ++i) { int R, C; stage_rc(tid * 16 + i * 8192, R, C); const int Rb = Epi::PERM ? ((R & ~31) + perm32(R & 31)) : R;
        voffA[i] = (unsigned)(R * K + C) * 2u; voffB[i] = (unsigned)(Rb * K + C) * 2u; }
    const size_t kstep = (size_t)(BK * 2);
    const size_t hstep = (size_t)HALF * K * 2;
    const size_t tstep = 2 * hstep;
    const unsigned ldsw = (unsigned)wid * 1024u;
    const int aoff = lds_byte(wr * 64 + fr, fq * 8), boff = lds_byte(wc * 32 + fr, fq * 8);
#define PG8_SA(b, h) (((b) * 2 + (h)) * HTB)
#define PG8_SB(b, h) ((4 + (b) * 2 + (h)) * HTB)
#define PG8_STAGE(bufoff, gbase, voff) do { _Pragma("unroll") for (int _i = 0; _i < 2; ++_i) \
        __builtin_amdgcn_global_load_lds((const unsigned*)((const char*)(gbase) + (voff)[_i]), (PG8_LAS unsigned*)(lds + (bufoff) + ldsw + _i * 8192), 16, 0, 0); } while (0)
#define PG8_LDA(dst, b, h) do { _Pragma("unroll") for (int m = 0; m < 4; ++m) _Pragma("unroll") for (int k = 0; k < 2; ++k) dst[m][k] = *(const PG8_LAS bf16x8*)(lds + PG8_SA(b, h) + aoff + m * 2048 + k * 1024); } while (0)
#define PG8_LDB(dst, b, h) do { _Pragma("unroll") for (int n = 0; n < 2; ++n) _Pragma("unroll") for (int k = 0; k < 2; ++k) dst[n][k] = *(const PG8_LAS bf16x8*)(lds + PG8_SB(b, h) + boff + n * 2048 + k * 1024); } while (0)
#define PG8_MMA(ai, bj, At, Bt) do { __builtin_amdgcn_s_setprio(1); _Pragma("unroll") for (int m = 0; m < 4; ++m) _Pragma("unroll") for (int n = 0; n < 2; ++n) _Pragma("unroll") for (int k = 0; k < 2; ++k) \
        acc[ai][bj][m][n] = __builtin_amdgcn_mfma_f32_16x16x32_bf16(Bt[n][k], At[m][k], acc[ai][bj][m][n], 0, 0, 0); __builtin_amdgcn_s_setprio(0); } while (0)
#define PG8_WAIT_V(n) asm volatile("s_waitcnt vmcnt(" #n ")" ::: "memory")
#define PG8_WAIT_L(n) asm volatile("s_waitcnt lgkmcnt(" #n ")" ::: "memory")
#define PG8_BAR __builtin_amdgcn_s_barrier()
#define PG8_SCHED __builtin_amdgcn_sched_barrier(0)
    Unit cur, nxt; int ui = 0;
    if (!S.next(0, cur)) return;
    f32x4 acc[2][2][4][2];
#pragma unroll
    for (int a = 0; a < 2; ++a)
#pragma unroll
        for (int b = 0; b < 2; ++b)
#pragma unroll
            for (int m = 0; m < 4; ++m)
#pragma unroll
                for (int n = 0; n < 2; ++n) acc[a][b][m][n] = (f32x4){0.f, 0.f, 0.f, 0.f};
    bf16x8 At[4][2], B0[2][2], B1[2][2];
    const char* cA = (const char*)g.A + (size_t)cur.pm * tstep; const char* cB = (const char*)g.Bt + (size_t)cur.pn * tstep;
    S.a_ready(cur);
    if constexpr (SP2) {
        PG8_STAGE(PG8_SB(0, 0), cB, voffB); PG8_STAGE(PG8_SB(0, 1), cB + hstep, voffB); PG8_STAGE(PG8_SA(0, 0), cA, voffA); PG8_STAGE(PG8_SA(0, 1), cA + hstep, voffA);
        if (wr == 1) PG8_BAR;
        PG8_WAIT_V(2); PG8_BAR;
        PG8_STAGE(PG8_SB(1, 0), cB + kstep, voffB); PG8_STAGE(PG8_SA(1, 0), cA + kstep, voffA); PG8_STAGE(PG8_SB(1, 1), cB + hstep + kstep, voffB);
        PG8_WAIT_V(6); PG8_BAR;
    } else {
        PG8_STAGE(PG8_SB(0, 0), cB, voffB); PG8_STAGE(PG8_SA(0, 0), cA, voffA); PG8_STAGE(PG8_SB(0, 1), cB + hstep, voffB); PG8_STAGE(PG8_SA(0, 1), cA + hstep, voffA);
        if (wr == 1) PG8_BAR;
        PG8_WAIT_V(4); PG8_BAR;
        PG8_STAGE(PG8_SB(1, 0), cB + kstep, voffB); PG8_STAGE(PG8_SA(1, 0), cA + kstep, voffA); PG8_STAGE(PG8_SB(1, 1), cB + hstep + kstep, voffB);
        PG8_WAIT_V(6); PG8_BAR;
    }
    for (;;) {
        const bool has_next = S.next(ui + 1, nxt);
        const char* nA = has_next ? (const char*)g.A + (size_t)nxt.pm * tstep : cA; const char* nB = has_next ? (const char*)g.Bt + (size_t)nxt.pn * tstep : cB;
        for (int t = 0; t < nt; t += 2) {
            const bool last = (t == nt - 2);
            const char* a1 = cA + (size_t)(t + 1) * kstep;
            const char* a2 = last ? nA : cA + (size_t)(t + 2) * kstep; const char* b2 = last ? nB : cB + (size_t)(t + 2) * kstep;
            const char* a3 = a2 + kstep; const char* b3 = b2 + kstep;
            if (last && has_next) S.a_ready(nxt);
            if constexpr (Epi::MIDHOOK) { if (t == (nt >> 1)) E.mid(acc, cur, wr, wc, fr, fq); }
            if constexpr (SP2) {
            PG8_LDB(B0, 0, 0); PG8_LDB(B1, 0, 1); PG8_SCHED; PG8_LDA(At, 0, 0); PG8_STAGE(PG8_SA(1, 1), a1 + hstep, voffA);
            PG8_WAIT_V(8); PG8_WAIT_L(0); PG8_BAR; PG8_MMA(0, 0, At, B0); PG8_MMA(0, 1, At, B1); PG8_BAR; PG8_SCHED;
            PG8_LDA(At, 0, 1); PG8_STAGE(PG8_SB(0, 0), b2, voffB); PG8_STAGE(PG8_SB(0, 1), b2 + hstep, voffB); PG8_STAGE(PG8_SA(0, 0), a2, voffA);
            PG8_WAIT_V(8); PG8_WAIT_L(0); PG8_BAR; PG8_MMA(1, 0, At, B0); PG8_MMA(1, 1, At, B1); PG8_BAR; PG8_SCHED;
            PG8_LDB(B0, 1, 0); PG8_LDB(B1, 1, 1); PG8_SCHED; PG8_LDA(At, 1, 0); PG8_STAGE(PG8_SA(0, 1), a2 + hstep, voffA);
            PG8_WAIT_V(8); PG8_WAIT_L(0); PG8_BAR; PG8_MMA(0, 0, At, B0); PG8_MMA(0, 1, At, B1); PG8_BAR; PG8_SCHED;
            PG8_LDA(At, 1, 1); PG8_STAGE(PG8_SB(1, 0), b3, voffB); PG8_STAGE(PG8_SB(1, 1), b3 + hstep, voffB); PG8_STAGE(PG8_SA(1, 0), a3, voffA);
            PG8_WAIT_V(8); PG8_WAIT_L(0); PG8_BAR; PG8_MMA(1, 0, At, B0); PG8_MMA(1, 1, At, B1); PG8_BAR; PG8_SCHED;
            } else {
            PG8_LDB(B0, 0, 0); PG8_SCHED; PG8_LDA(At, 0, 0); PG8_STAGE(PG8_SA(1, 1), a1 + hstep, voffA);
            PG8_WAIT_L(8); PG8_BAR; PG8_WAIT_L(0); PG8_MMA(0, 0, At, B0); PG8_BAR; PG8_SCHED;
            PG8_LDB(B1, 0, 1); PG8_STAGE(PG8_SB(0, 0), b2, voffB);
            PG8_BAR; PG8_WAIT_L(0); PG8_MMA(0, 1, At, B1); PG8_BAR;
            PG8_LDA(At, 0, 1); PG8_STAGE(PG8_SA(0, 0), a2, voffA);
            PG8_BAR; PG8_WAIT_L(0); PG8_MMA(1, 0, At, B0); PG8_BAR; PG8_SCHED;
            PG8_STAGE(PG8_SB(0, 1), b2 + hstep, voffB);
            PG8_WAIT_V(6); PG8_BAR; PG8_MMA(1, 1, At, B1); PG8_BAR;
            PG8_LDB(B0, 1, 0); PG8_SCHED; PG8_LDA(At, 1, 0); PG8_STAGE(PG8_SA(0, 1), a2 + hstep, voffA);
            PG8_WAIT_L(8); PG8_BAR; PG8_WAIT_L(0); PG8_MMA(0, 0, At, B0); PG8_BAR; PG8_SCHED;
            PG8_LDB(B1, 1, 1); PG8_STAGE(PG8_SB(1, 0), b3, voffB);
            PG8_BAR; PG8_WAIT_L(0); PG8_MMA(0, 1, At, B1); PG8_BAR;
            PG8_LDA(At, 1, 1); PG8_STAGE(PG8_SA(1, 0), a3, voffA);
            PG8_BAR; PG8_WAIT_L(0); PG8_MMA(1, 0, At, B0); PG8_BAR; PG8_SCHED;
            PG8_STAGE(PG8_SB(1, 1), b3 + hstep, voffB);
            PG8_WAIT_V(6); PG8_BAR; PG8_MMA(1, 1, At, B1); PG8_BAR;
            }
        }
        if constexpr (ALIGN_EPI) { if (wr == 0) PG8_BAR; }
        if constexpr (!Epi::AFTER_DRAIN) { E(acc, cur, wr, wc, fr, fq); S.done(cur); }
        if (!has_next) break;
#pragma unroll
        for (int a = 0; a < 2; ++a)
#pragma unroll
            for (int b = 0; b < 2; ++b)
#pragma unroll
                for (int m = 0; m < 4; ++m)
#pragma unroll
                    for (int n = 0; n < 2; ++n) acc[a][b][m][n] = (f32x4){0.f, 0.f, 0.f, 0.f};
        cur = nxt; cA = nA; cB = nB; ++ui;
        if constexpr (ALIGN_EPI) { if (wr == 1) PG8_BAR; }
    }
    PG8_WAIT_V(0);
    if constexpr (!ALIGN_EPI) { if (wr == 0) PG8_BAR; }
    PG8_BAR;
    if constexpr (Epi::AFTER_DRAIN) { E.fused(acc, cur, wr, wc, fr, fq, lds, wid, lane); S.done(cur); }
#undef PG8_SA
#undef PG8_SB
#undef PG8_STAGE
#undef PG8_LDA
#undef PG8_LDB
#undef PG8_MMA
#undef PG8_WAIT_V
#undef PG8_WAIT_L
#undef PG8_BAR
#undef PG8_SCHED
}
struct Gemm2 { const bf16_t* A; const bf16_t* A2; const bf16_t* Bt; int M, N, K, lda, lda2, tsplit; };
template <class Epi, class Sched, bool ALIGN_EPI = false, bool SP2 = false>
__device__ __forceinline__ void gemm_phase_split(PG8_LAS unsigned char* lds, const Gemm2 g, const Sched& S, const Epi& E) {
    int tid_ = threadIdx.x; asm volatile("" : "+v"(tid_));
    const int tid = tid_, wid = __builtin_amdgcn_readfirstlane(tid >> 6), lane = tid & 63, wr = wid >> 2, wc = wid & 3, fr = lane & 15, fq = lane >> 4;
    const int K = g.K, nt = K / BK;
    unsigned voffA[2], voffA2[2], voffB[2]; const int ts = g.tsplit;
#pragma unroll
    for (int i = 0; i < 2; ++i) { int R, C; stage_rc(tid * 16 + i * 8192, R, C); const int Rb = Epi::PERM ? ((R & ~31) + perm32(R & 31)) : R;
        voffA[i] = (unsigned)(R * g.lda + C) * 2u; voffA2[i] = (unsigned)(R * g.lda2 + C) * 2u; voffB[i] = (unsigned)(Rb * K + C) * 2u; }
    const size_t kstep = (size_t)(BK * 2);
    const size_t hstepA = (size_t)HALF * g.lda * 2, hstepA2 = (size_t)HALF * g.lda2 * 2, hstepB = (size_t)HALF * K * 2;
    const size_t tstepA = 2 * hstepA, tstepA2 = 2 * hstepA2, tstepB = 2 * hstepB;
    const unsigned ldsw = (unsigned)wid * 1024u;
    const int aoff = lds_byte(wr * 64 + fr, fq * 8), boff = lds_byte(wc * 32 + fr, fq * 8);
#define PG8_SA(b, h) (((b) * 2 + (h)) * HTB)
#define PG8_SB(b, h) ((4 + (b) * 2 + (h)) * HTB)
#define PG8_STAGE(bufoff, gbase, voff) do { _Pragma("unroll") for (int _i = 0; _i < 2; ++_i) \
        __builtin_amdgcn_global_load_lds((const unsigned*)((const char*)(gbase) + (voff)[_i]), (PG8_LAS unsigned*)(lds + (bufoff) + ldsw + _i * 8192), 16, 0, 0); } while (0)
#define PG8_LDA(dst, b, h) do { _Pragma("unroll") for (int m = 0; m < 4; ++m) _Pragma("unroll") for (int k = 0; k < 2; ++k) dst[m][k] = *(const PG8_LAS bf16x8*)(lds + PG8_SA(b, h) + aoff + m * 2048 + k * 1024); } while (0)
#define PG8_LDB(dst, b, h) do { _Pragma("unroll") for (int n = 0; n < 2; ++n) _Pragma("unroll") for (int k = 0; k < 2; ++k) dst[n][k] = *(const PG8_LAS bf16x8*)(lds + PG8_SB(b, h) + boff + n * 2048 + k * 1024); } while (0)
#define PG8_MMA(ai, bj, At, Bt) do { __builtin_amdgcn_s_setprio(1); _Pragma("unroll") for (int m = 0; m < 4; ++m) _Pragma("unroll") for (int n = 0; n < 2; ++n) _Pragma("unroll") for (int k = 0; k < 2; ++k) \
        acc[ai][bj][m][n] = __builtin_amdgcn_mfma_f32_16x16x32_bf16(Bt[n][k], At[m][k], acc[ai][bj][m][n], 0, 0, 0); __builtin_amdgcn_s_setprio(0); } while (0)
#define PG8_WAIT_V(n) asm volatile("s_waitcnt vmcnt(" #n ")" ::: "memory")
#define PG8_WAIT_L(n) asm volatile("s_waitcnt lgkmcnt(" #n ")" ::: "memory")
#define PG8_BAR __builtin_amdgcn_s_barrier()
#define PG8_SCHED __builtin_amdgcn_sched_barrier(0)
    Unit cur, nxt; int ui = 0;
    if (!S.next(0, cur)) return;
    f32x4 acc[2][2][4][2];
#pragma unroll
    for (int a = 0; a < 2; ++a)
#pragma unroll
        for (int b = 0; b < 2; ++b)
#pragma unroll
            for (int m = 0; m < 4; ++m)
#pragma unroll
                for (int n = 0; n < 2; ++n) acc[a][b][m][n] = (f32x4){0.f, 0.f, 0.f, 0.f};
    bf16x8 At[4][2], B0[2][2], B1[2][2];
    const char* cA = (const char*)g.A + (size_t)cur.pm * tstepA; const char* cA2 = (const char*)g.A2 + (size_t)cur.pm * tstepA2; const char* cB = (const char*)g.Bt + (size_t)cur.pn * tstepB;
    S.a_ready(cur);
    if constexpr (SP2) {
        PG8_STAGE(PG8_SB(0, 0), cB, voffB); PG8_STAGE(PG8_SB(0, 1), cB + hstepB, voffB); PG8_STAGE(PG8_SA(0, 0), cA, voffA); PG8_STAGE(PG8_SA(0, 1), cA + hstepA, voffA);
        if (wr == 1) PG8_BAR;
        PG8_WAIT_V(2); PG8_BAR;
        PG8_STAGE(PG8_SB(1, 0), cB + kstep, voffB); PG8_STAGE(PG8_SA(1, 0), cA + kstep, voffA); PG8_STAGE(PG8_SB(1, 1), cB + hstepB + kstep, voffB);
        PG8_WAIT_V(6); PG8_BAR;
    } else {
        PG8_STAGE(PG8_SB(0, 0), cB, voffB); PG8_STAGE(PG8_SA(0, 0), cA, voffA); PG8_STAGE(PG8_SB(0, 1), cB + hstepB, voffB); PG8_STAGE(PG8_SA(0, 1), cA + hstepA, voffA);
        if (wr == 1) PG8_BAR;
        PG8_WAIT_V(4); PG8_BAR;
        PG8_STAGE(PG8_SB(1, 0), cB + kstep, voffB); PG8_STAGE(PG8_SA(1, 0), cA + kstep, voffA); PG8_STAGE(PG8_SB(1, 1), cB + hstepB + kstep, voffB);
        PG8_WAIT_V(6); PG8_BAR;
    }
    for (;;) {
        const bool has_next = S.next(ui + 1, nxt);
        const char* nA = has_next ? (const char*)g.A + (size_t)nxt.pm * tstepA : cA; const char* nA2 = has_next ? (const char*)g.A2 + (size_t)nxt.pm * tstepA2 : cA2; const char* nB = has_next ? (const char*)g.Bt + (size_t)nxt.pn * tstepB : cB;
        for (int t = 0; t < nt; t += 2) {
            const bool last = (t == nt - 2);
            const bool s1 = (t >= ts), s2 = (!last && t + 2 >= ts);
            const char* a1 = s1 ? cA2 + (size_t)(t + 1 - ts) * kstep : cA + (size_t)(t + 1) * kstep; const size_t h1 = s1 ? hstepA2 : hstepA; const unsigned v1[2] = {s1 ? voffA2[0] : voffA[0], s1 ? voffA2[1] : voffA[1]};
            const char* a2 = last ? nA : (s2 ? cA2 + (size_t)(t + 2 - ts) * kstep : cA + (size_t)(t + 2) * kstep); const size_t h2 = s2 ? hstepA2 : hstepA; const unsigned v2[2] = {s2 ? voffA2[0] : voffA[0], s2 ? voffA2[1] : voffA[1]};
            const char* b2 = last ? nB : cB + (size_t)(t + 2) * kstep;
            const char* a3 = a2 + kstep; const char* b3 = b2 + kstep;
            if (last && has_next) S.a_ready(nxt);
            if (t == ts) E.mid(acc, cur, wr, wc, fr, fq);
            if constexpr (SP2) {
            PG8_LDB(B0, 0, 0); PG8_LDB(B1, 0, 1); PG8_SCHED; PG8_LDA(At, 0, 0); PG8_STAGE(PG8_SA(1, 1), a1 + h1, v1);
            PG8_WAIT_V(8); PG8_WAIT_L(0); PG8_BAR; PG8_MMA(0, 0, At, B0); PG8_MMA(0, 1, At, B1); PG8_BAR; PG8_SCHED;
            PG8_LDA(At, 0, 1); PG8_STAGE(PG8_SB(0, 0), b2, voffB); PG8_STAGE(PG8_SB(0, 1), b2 + hstepB, voffB); PG8_STAGE(PG8_SA(0, 0), a2, v2);
            PG8_WAIT_V(8); PG8_WAIT_L(0); PG8_BAR; PG8_MMA(1, 0, At, B0); PG8_MMA(1, 1, At, B1); PG8_BAR; PG8_SCHED;
            PG8_LDB(B0, 1, 0); PG8_LDB(B1, 1, 1); PG8_SCHED; PG8_LDA(At, 1, 0); PG8_STAGE(PG8_SA(0, 1), a2 + h2, v2);
            PG8_WAIT_V(8); PG8_WAIT_L(0); PG8_BAR; PG8_MMA(0, 0, At, B0); PG8_MMA(0, 1, At, B1); PG8_BAR; PG8_SCHED;
            PG8_LDA(At, 1, 1); PG8_STAGE(PG8_SB(1, 0), b3, voffB); PG8_STAGE(PG8_SB(1, 1), b3 + hstepB, voffB); PG8_STAGE(PG8_SA(1, 0), a3, v2);
            PG8_WAIT_V(8); PG8_WAIT_L(0); PG8_BAR; PG8_MMA(1, 0, At, B0); PG8_MMA(1, 1, At, B1); PG8_BAR; PG8_SCHED;
            } else {
            PG8_LDB(B0, 0, 0); PG8_SCHED; PG8_LDA(At, 0, 0); PG8_STAGE(PG8_SA(1, 1), a1 + h1, v1);
            PG8_WAIT_L(8); PG8_BAR; PG8_WAIT_L(0); PG8_MMA(0, 0, At, B0); PG8_BAR; PG8_SCHED;
            PG8_LDB(B1, 0, 1); PG8_STAGE(PG8_SB(0, 0), b2, voffB);
            PG8_BAR; PG8_WAIT_L(0); PG8_MMA(0, 1, At, B1); PG8_BAR;
            PG8_LDA(At, 0, 1); PG8_STAGE(PG8_SA(0, 0), a2, v2);
            PG8_BAR; PG8_WAIT_L(0); PG8_MMA(1, 0, At, B0); PG8_BAR; PG8_SCHED;
            PG8_STAGE(PG8_SB(0, 1), b2 + hstepB, voffB);
            PG8_WAIT_V(6); PG8_BAR; PG8_MMA(1, 1, At, B1); PG8_BAR;
            PG8_LDB(B0, 1, 0); PG8_SCHED; PG8_LDA(At, 1, 0); PG8_STAGE(PG8_SA(0, 1), a2 + h2, v2);
            PG8_WAIT_L(8); PG8_BAR; PG8_WAIT_L(0); PG8_MMA(0, 0, At, B0); PG8_BAR; PG8_SCHED;
            PG8_LDB(B1, 1, 1); PG8_STAGE(PG8_SB(1, 0), b3, voffB);
            PG8_BAR; PG8_WAIT_L(0); PG8_MMA(0, 1, At, B1); PG8_BAR;
            PG8_LDA(At, 1, 1); PG8_STAGE(PG8_SA(1, 0), a3, v2);
            PG8_BAR; PG8_WAIT_L(0); PG8_MMA(1, 0, At, B0); PG8_BAR; PG8_SCHED;
            PG8_STAGE(PG8_SB(1, 1), b3 + hstepB, voffB);
            PG8_WAIT_V(6); PG8_BAR; PG8_MMA(1, 1, At, B1); PG8_BAR;
            }
        }
        if constexpr (ALIGN_EPI) { if (wr == 0) PG8_BAR; }
        if constexpr (!Epi::AFTER_DRAIN) { E(acc, cur, wr, wc, fr, fq); S.done(cur); }
        if (!has_next) break;
#pragma unroll
        for (int a = 0; a < 2; ++a)
#pragma unroll
            for (int b = 0; b < 2; ++b)
#pragma unroll
                for (int m = 0; m < 4; ++m)
#pragma unroll
                    for (int n = 0; n < 2; ++n) acc[a][b][m][n] = (f32x4){0.f, 0.f, 0.f, 0.f};
        cur = nxt; cA = nA; cA2 = nA2; cB = nB; ++ui;
        if constexpr (ALIGN_EPI) { if (wr == 1) PG8_BAR; }
    }
    PG8_WAIT_V(0);
    if constexpr (!ALIGN_EPI) { if (wr == 0) PG8_BAR; }
    PG8_BAR;
    if constexpr (Epi::AFTER_DRAIN) { E.fused(acc, cur, wr, wc, fr, fq, lds, wid, lane); S.done(cur); }
#undef PG8_SA
#undef PG8_SB
#undef PG8_STAGE
#undef PG8_LDA
#undef PG8_LDB
#undef PG8_MMA
#undef PG8_WAIT_V
#undef PG8_WAIT_L
#undef PG8_BAR
#undef PG8_SCHED
}
}

constexpr int NWAVES = 8;
constexpr int BATCH = 4, SEQ = 8192, D = 1024, M = BATCH * SEQ, DIN = 5120, FF = 4096, PLE = 256, AW = 512, NH = 8, HD = 64;
constexpr float EPS = 1e-6f;
constexpr int C_Q = 0, C_K = 512, C_V = 1024, C_CB = 1536, C_CC = 2048, C_CU = 2560, C_GA = 3072, C_GC = 4096;
constexpr size_t MiB = 1u << 20;
constexpr size_t WS_WIN = 1 * MiB, WS_WA = 11 * MiB, WS_WC = 12 * MiB, WS_WO = 13 * MiB, WS_WUP = 15 * MiB, WS_WDN = 23 * MiB, WS_WPG = 31 * MiB, WS_WPP = 33 * MiB;
constexpr size_t WS_R1 = 34 * MiB;
constexpr size_t WS_R2 = 98 * MiB;
constexpr size_t WS_R3 = 162 * MiB;
constexpr size_t WS_PB = 482 * MiB;
constexpr size_t WS_XB = 500 * MiB;
constexpr size_t WS_SS2 = 501 * MiB, WS_SS3 = 503 * MiB;
constexpr size_t WS_END = 505 * MiB;
constexpr size_t WS_CNT = 65536;
constexpr int RING_BYTES = 131072, LDS_BYTES = 147456;

#define GAS __attribute__((address_space(1)))
#define LAS __attribute__((address_space(3)))
typedef unsigned short bf16;
typedef unsigned v4u __attribute__((ext_vector_type(4)));
typedef unsigned v2u __attribute__((ext_vector_type(2)));
typedef float f32x4 __attribute__((ext_vector_type(4)));
typedef float f32x16 __attribute__((ext_vector_type(16)));
typedef short bf16x8 __attribute__((ext_vector_type(8)));
using pg8::pk_bf16; using pg8::bf_lo; using pg8::bf_hi;
#define LDS_WAIT() asm volatile("s_waitcnt lgkmcnt(0)" ::: "memory")

#define XB_TMO      128
#define XB_XCNT(j)  (256  + 64 * (j))
#define XB_XSUB(j)  (1280 + 64 * (j))
#define XB_XGEN(j)  (2304 + 64 * (j))
#define XB_TOP      3328
#define XB_TOPGEN   3392
#define XCD_BAR_WORDS 3456
#define XB_SPIN_CAP (1u << 18)

__device__ __forceinline__ unsigned xb_ld(unsigned* p)              { return __hip_atomic_load(p, __ATOMIC_RELAXED, __HIP_MEMORY_SCOPE_AGENT); }
__device__ __forceinline__ unsigned xb_add(unsigned* p, unsigned v) { return __hip_atomic_fetch_add(p, v, __ATOMIC_RELAXED, __HIP_MEMORY_SCOPE_AGENT); }
__device__ __forceinline__ unsigned xb_xcc_id() { return (unsigned)__builtin_amdgcn_s_getreg((3 << 11) | 20) & 0xFu; }
#define XB_SPIN(cond, bar) do { unsigned _sp = 0; while (cond) { __builtin_amdgcn_s_sleep(1); \
    if ((++_sp & 255u) == 0u) { if (xb_ld(&(bar)[XB_TMO])) break; if (_sp > XB_SPIN_CAP) { atomicAdd(&(bar)[XB_TMO], 1u); break; } } } } while (0)

struct XcdBarrier {
    unsigned* bar; unsigned x;
    volatile LAS unsigned* st;
};

__device__ __forceinline__ XcdBarrier xcd_barrier_post(unsigned* bar, volatile LAS unsigned* st) {
    XcdBarrier b; b.bar = bar; b.x = xb_xcc_id(); b.st = st;
    if (threadIdx.x == 0) (void)xb_add(&bar[XB_XCNT(b.x)], 1u);
    return b;
}
__device__ __forceinline__ void xcd_barrier_complete(unsigned* bar, unsigned x, unsigned& nloc, unsigned& nx) {
    const unsigned G = gridDim.x * gridDim.y * gridDim.z;
    unsigned sum, cnt, mine, sp = 0u;
    for (;;) {
        sum = 0u; cnt = 0u; mine = 0u;
#pragma unroll
        for (unsigned j = 0; j < 16; ++j) { const unsigned c = xb_ld(&bar[XB_XCNT(j)]); sum += c; cnt += (c > 0u) ? 1u : 0u; mine = (j == x) ? c : mine; }
        if (sum == G) break;
        __builtin_amdgcn_s_sleep(1);
        if ((++sp & 255u) == 0u) { if (xb_ld(&bar[XB_TMO])) break; if (sp > XB_SPIN_CAP) { atomicAdd(&bar[XB_TMO], 1u); break; } }
    }
    nloc = mine > 0u ? mine : 1u; nx = cnt > 0u ? cnt : 1u;
}

__device__ __forceinline__ void xcd_barrier(const XcdBarrier& b) {
    asm volatile("s_waitcnt vmcnt(0)" ::: "memory");
    __syncthreads();
    if (threadIdx.x == 0) {
        unsigned* bar = b.bar;
        __builtin_amdgcn_s_waitcnt(0);
        unsigned nloc = b.st[0], nx = b.st[1];
        if (nloc == 0u) { xcd_barrier_complete(bar, b.x, nloc, nx); b.st[0] = nloc; b.st[1] = nx; }
        const unsigned old = xb_add(&bar[XB_XSUB(b.x)], 1u);
        const unsigned gen = old / nloc;
        if (old + 1u == (gen + 1u) * nloc) {
            __builtin_amdgcn_fence(__ATOMIC_RELEASE, "agent");
            asm volatile("s_waitcnt vmcnt(0)" ::: "memory");
            const unsigned og = xb_add(&bar[XB_TOP], 1u);
            const unsigned tg = og / nx;
            if (og + 1u == (tg + 1u) * nx) xb_add(&bar[XB_TOPGEN], 1u);
            else XB_SPIN(xb_ld(&bar[XB_TOPGEN]) == tg, bar);
            __builtin_amdgcn_fence(__ATOMIC_ACQUIRE, "agent");
            xb_add(&bar[XB_XGEN(b.x)], 1u);
            asm volatile("s_waitcnt vmcnt(0)" ::: "memory");
        } else {
            XB_SPIN(xb_ld(&bar[XB_XGEN(b.x)]) == gen, bar);
            __builtin_amdgcn_fence(__ATOMIC_ACQUIRE, "agent");
            asm volatile("s_waitcnt vmcnt(0)" ::: "memory");
        }
    }
    __syncthreads();
}


__device__ __forceinline__ float wave_sum(float v) {
#pragma unroll
    for (int o = 1; o < 64; o <<= 1) v += __shfl_xor(v, o);
    return v;
}
__device__ __forceinline__ void p0_transpose_item(const float* W, int K, int N, bf16* WT, LAS float* scr, int item, int lane, const float* gain = nullptr, int ldw = 0, bool permin = false) {
    const int nblk = N / 32, kb = item / nblk, nb = item % nblk, k0 = 64 * kb, n0 = 32 * nb;
    int sn0 = n0;
    if (permin && n0 >= 2048) { const int base = n0 < 3072 ? 2048 : 3072, half = n0 < 3072 ? 512 : 1024, t = n0 - base, j = t >> 8, w = t & 255; sn0 = base + (w < 128 ? 0 : half) + 128 * j + (w & 127); }
    { const int cq = lane & 7;
#pragma unroll
      for (int i = 0; i < 8; ++i) { const int kk = 8 * i + (lane >> 3); f32x4 v = *(const f32x4*)(W + (size_t)(k0 + kk) * N + sn0 + 4 * cq); if (gain) v = v * gain[k0 + kk];
          LAS float* d = scr + kk * 33 + 4 * cq; d[0] = v.x; d[1] = v.y; d[2] = v.z; d[3] = v.w; } }
    LDS_WAIT(); asm volatile("" ::: "memory");
    const int c = lane & 7;
#pragma unroll
    for (int j = 0; j < 4; ++j) { const int n = (lane >> 3) + 8 * j; const LAS float* s = scr + (8 * c) * 33 + n;
        v4u o; o.x = pk_bf16(s[0 * 33], s[1 * 33]); o.y = pk_bf16(s[2 * 33], s[3 * 33]); o.z = pk_bf16(s[4 * 33], s[5 * 33]); o.w = pk_bf16(s[6 * 33], s[7 * 33]);
        *(v4u*)(WT + (size_t)(n0 + n) * (ldw ? ldw : K) + k0 + 8 * c) = o; }
    LDS_WAIT(); asm volatile("" ::: "memory");
}
__device__ __forceinline__ void rms_row_to_bf16(const float* xrow, const float* g, bf16* orow, int lane) {
    const f32x4* xr = (const f32x4*)xrow + lane; const f32x4* gr = (const f32x4*)g + lane;
    f32x4 v[4]; float s = 0.f;
#pragma unroll
    for (int j = 0; j < 4; ++j) { v[j] = xr[64 * j]; s += (v[j].x * v[j].x + v[j].y * v[j].y) + (v[j].z * v[j].z + v[j].w * v[j].w); }
    const float rstd = 1.0f / sqrtf(wave_sum(s) * (1.f / D) + EPS);
    v2u* o8 = (v2u*)orow + lane;
#pragma unroll
    for (int j = 0; j < 4; ++j) { const f32x4 gg = gr[64 * j]; v2u w; w.x = pk_bf16(v[j].x * rstd * gg.x, v[j].y * rstd * gg.y); w.y = pk_bf16(v[j].z * rstd * gg.z, v[j].w * rstd * gg.w); o8[64 * j] = w; }
}
__device__ __forceinline__ void res_norm_row(const bf16* yrow, const float* base, float* out, const float* g1, const float* g2, bf16* xn, int lane) {
    const v2u* yr = (const v2u*)yrow + lane; const f32x4* br = (const f32x4*)base + lane; const f32x4* g1r = (const f32x4*)g1 + lane; const f32x4* g2r = (const f32x4*)g2 + lane;
    f32x4 y[4], x[4]; float s = 0.f;
#pragma unroll
    for (int j = 0; j < 4; ++j) { const v2u w = yr[64 * j]; y[j] = (f32x4){bf_lo(w.x), bf_hi(w.x), bf_lo(w.y), bf_hi(w.y)}; x[j] = br[64 * j];
        s += (y[j].x * y[j].x + y[j].y * y[j].y) + (y[j].z * y[j].z + y[j].w * y[j].w); }
    const float rstd = 1.0f / sqrtf(wave_sum(s) * (1.f / D) + EPS);
    float s2 = 0.f;
#pragma unroll
    for (int j = 0; j < 4; ++j) { const f32x4 gg = g1r[64 * j]; x[j] = x[j] + y[j] * rstd * gg; s2 += (x[j].x * x[j].x + x[j].y * x[j].y) + (x[j].z * x[j].z + x[j].w * x[j].w); }
    f32x4* orow = (f32x4*)out + lane;
#pragma unroll
    for (int j = 0; j < 4; ++j) orow[64 * j] = x[j];
    const float rstd2 = 1.0f / sqrtf(wave_sum(s2) * (1.f / D) + EPS);
    v2u* o8 = (v2u*)xn + lane;
#pragma unroll
    for (int j = 0; j < 4; ++j) { const f32x4 gg = g2r[64 * j]; v2u w; w.x = pk_bf16(x[j].x * rstd2 * gg.x, x[j].y * rstd2 * gg.y); w.y = pk_bf16(x[j].z * rstd2 * gg.z, x[j].w * rstd2 * gg.w); o8[64 * j] = w; }
}

#define MFMA32(a, b, c) __builtin_amdgcn_mfma_f32_32x32x16_bf16((a), (b), (c), 0, 0, 0)
__device__ __forceinline__ void attn_load(const bf16* __restrict__ PROJ, size_t rowbase, int h, int k0, int r, int hh, bf16x8 (&kf)[4], unsigned (&vr)[32]) {
    const bf16* vp = PROJ + (rowbase + k0 + 4 * hh) * DIN + C_V + h * HD + r;
#pragma unroll
    for (int s = 0; s < 2; ++s)
#pragma unroll
        for (int dh = 0; dh < 2; ++dh)
#pragma unroll
            for (int j = 0; j < 8; ++j) vr[(s * 2 + dh) * 8 + j] = vp[(size_t)(16 * s + 8 * (j >> 2) + (j & 3)) * DIN + 32 * dh];
    asm volatile("" ::: "memory");
    const bf16* kp = PROJ + (rowbase + k0 + r) * DIN + C_K + h * HD + 8 * hh;
#pragma unroll
    for (int ds = 0; ds < 4; ++ds) kf[ds] = *(const bf16x8*)(kp + 16 * ds);
}
__device__ __forceinline__ void attn_block(const bf16x8 (&kf)[4], unsigned (&vr)[32], const bf16x8 (&qf)[4], bool diag, int r, int hh, float& A2, f32x16& o0, f32x16& o1,
                                           const bf16* __restrict__ PROJ, size_t rowbase, int h, int knext, bf16x8 (&kfN)[4], unsigned (&vrN)[32]) {
    f32x16 st;
#pragma unroll
    for (int i = 0; i < 16; ++i) st[i] = 0.f;
#pragma unroll
    for (int ds = 0; ds < 4; ++ds) st = MFMA32(kf[ds], qf[ds], st);
    attn_load(PROJ, rowbase, h, knext, r, hh, kfN, vrN);
    { float anchor = st[0];
#pragma unroll
      for (int i = 0; i < 32; ++i) asm volatile("" : "+v"(vr[i]), "+v"(anchor));
      st[0] = anchor; }
    bf16x8 va[2][2];
#pragma unroll
    for (int s = 0; s < 2; ++s)
#pragma unroll
        for (int dh = 0; dh < 2; ++dh) { v4u pk;
            pk.x = vr[(s * 2 + dh) * 8 + 0] | (vr[(s * 2 + dh) * 8 + 1] << 16); pk.y = vr[(s * 2 + dh) * 8 + 2] | (vr[(s * 2 + dh) * 8 + 3] << 16);
            pk.z = vr[(s * 2 + dh) * 8 + 4] | (vr[(s * 2 + dh) * 8 + 5] << 16); pk.w = vr[(s * 2 + dh) * 8 + 6] | (vr[(s * 2 + dh) * 8 + 7] << 16);
            va[s][dh] = __builtin_bit_cast(bf16x8, pk); }
    float lk[16], lb[16];
#pragma unroll
    for (int i = 0; i < 16; ++i) {
        const float z2 = st[i] * (0.125f * 1.4426950408889634f);
        const float l2 = __builtin_amdgcn_logf(1.0f + __builtin_amdgcn_exp2f(-fabsf(z2)));
        lb[i] = fminf(z2, 0.f) - l2;
        lk[i] = lb[i] - z2;
    }
    if (diag) {
#pragma unroll
        for (int i = 0; i < 16; ++i) { const int kk = (i & 3) + 8 * (i >> 2) + 4 * hh; if (!(kk < r)) { lk[i] = 0.f; lb[i] = -INFINITY; } }
    }
    float within[16], c[4], cp[4];
#pragma unroll
    for (int g = 0; g < 4; ++g) { const float s3 = lk[4 * g + 3], s2 = s3 + lk[4 * g + 2], s1 = s2 + lk[4 * g + 1]; c[g] = s1 + lk[4 * g];
        within[4 * g + 3] = 0.f; within[4 * g + 2] = s3; within[4 * g + 1] = s2; within[4 * g] = s1; }
    float Tg[4];
#pragma unroll
    for (int g = 0; g < 4; ++g) {
        const auto rr = __builtin_amdgcn_permlane32_swap(__float_as_uint(c[g]), __float_as_uint(c[g]), false, false);
        const float r0 = __uint_as_float(rr[0]), r1 = __uint_as_float(rr[1]);
        Tg[g] = r0 + r1; cp[g] = r1;
    }
    const float T0 = Tg[0], T1 = Tg[1], T2 = Tg[2], T3 = Tg[3];
    float suf[4]; suf[3] = 0.f; suf[2] = T3; suf[1] = T3 + T2; suf[0] = suf[1] + T1;
    const float total = suf[0] + T0;
    float w[16];
#pragma unroll
    for (int g = 0; g < 4; ++g) { const float base = A2 + suf[g] + (hh == 0 ? cp[g] : 0.f);
#pragma unroll
        for (int i = 0; i < 4; ++i) w[4 * g + i] = __builtin_amdgcn_exp2f(lb[4 * g + i] + (base + within[4 * g + i])); }
    v4u p0, p1;
    p0.x = pk_bf16(w[0], w[1]); p0.y = pk_bf16(w[2], w[3]); p0.z = pk_bf16(w[4], w[5]); p0.w = pk_bf16(w[6], w[7]);
    p1.x = pk_bf16(w[8], w[9]); p1.y = pk_bf16(w[10], w[11]); p1.z = pk_bf16(w[12], w[13]); p1.w = pk_bf16(w[14], w[15]);
    const bf16x8 x0 = __builtin_bit_cast(bf16x8, p0), x1 = __builtin_bit_cast(bf16x8, p1);
    o0 = MFMA32(va[0][0], x0, o0); o0 = MFMA32(va[1][0], x1, o0);
    o1 = MFMA32(va[0][1], x0, o1); o1 = MFMA32(va[1][1], x1, o1);
    A2 += total;
}
__device__ __forceinline__ void attn_unit(const bf16* __restrict__ PROJ, bf16* __restrict__ O, int b, int h, int qt, int lane) {
    const int r = lane & 31, hh = lane >> 5;
    const size_t rowbase = (size_t)b * SEQ;
    const int t0 = qt * 32;
    const bf16* qp = PROJ + (rowbase + t0 + r) * DIN + C_Q + h * HD + 8 * hh;
    bf16x8 qf[4];
#pragma unroll
    for (int ds = 0; ds < 4; ++ds) qf[ds] = *(const bf16x8*)(qp + 16 * ds);
    f32x16 o0, o1;
#pragma unroll
    for (int i = 0; i < 16; ++i) { o0[i] = 0.f; o1[i] = 0.f; }
    float A2 = 0.f;
#define ATT_DONE() (__builtin_amdgcn_ballot_w64(A2 > -127.0f) == 0ull)
    bf16x8 kfA[4], kfB[4]; unsigned vaA[32], vaB[32];
    attn_load(PROJ, rowbase, h, t0, r, hh, kfA, vaA);
    int kb = qt;
    for (;;) {
        attn_block(kfA, vaA, qf, kb == qt, r, hh, A2, o0, o1, PROJ, rowbase, h, (kb > 0 ? kb - 1 : 0) * 32, kfB, vaB);
        if (kb == 0 || ATT_DONE()) break;
        --kb;
        attn_block(kfB, vaB, qf, false, r, hh, A2, o0, o1, PROJ, rowbase, h, (kb > 0 ? kb - 1 : 0) * 32, kfA, vaA);
        if (kb == 0 || ATT_DONE()) break;
        --kb;
    }
#undef ATT_DONE
    bf16* op = O + (rowbase + t0 + r) * D + h * HD + 4 * hh;
#pragma unroll
    for (int g = 0; g < 4; ++g) {
        v2u a; a.x = pk_bf16(o0[4 * g], o0[4 * g + 1]); a.y = pk_bf16(o0[4 * g + 2], o0[4 * g + 3]); *(v2u*)(op + 8 * g) = a;
        v2u c2; c2.x = pk_bf16(o1[4 * g], o1[4 * g + 1]); c2.y = pk_bf16(o1[4 * g + 2], o1[4 * g + 3]); *(v2u*)(op + 32 + 8 * g) = c2;
    }
}
__device__ __forceinline__ void conv_item(const bf16* __restrict__ PROJ, const float* __restrict__ wconv, bf16* __restrict__ CM, int it) {
    const int cgp = it & 63, run = it >> 6, c0 = cgp * 8; const int t_start = run * 16; const bool first = (t_start % SEQ) == 0;
    f32x4 w0a = *(const f32x4*)(wconv + c0), w0b = *(const f32x4*)(wconv + c0 + 4), w1a = *(const f32x4*)(wconv + AW + c0), w1b = *(const f32x4*)(wconv + AW + c0 + 4),
          w2a = *(const f32x4*)(wconv + 2 * AW + c0), w2b = *(const f32x4*)(wconv + 2 * AW + c0 + 4);
    f32x4 m2a = {0.f, 0.f, 0.f, 0.f}, m2b = m2a, m1a = m2a, m1b = m2a;
    if (!first) {
        pg8::unpack8(*(const v4u*)(PROJ + (size_t)(t_start - 2) * DIN + C_CC + c0), m2a, m2b);
        pg8::unpack8(*(const v4u*)(PROJ + (size_t)(t_start - 1) * DIN + C_CC + c0), m1a, m1b);
    }
#pragma unroll 4
    for (int t = 0; t < 16; ++t) {
        const bf16* rowp = PROJ + (size_t)(t_start + t) * DIN + c0;
        f32x4 ma, mb, g0, g1;
        pg8::unpack8(*(const v4u*)(rowp + C_CC), ma, mb); pg8::unpack8(*(const v4u*)(rowp + C_CB), g0, g1);
        const f32x4 ra = g0 * (w0a * m2a + w1a * m1a + w2a * ma), rb = g1 * (w0b * m2b + w1b * m1b + w2b * mb);
        *(v4u*)(CM + (size_t)(t_start + t) * D + c0) = pg8::pack8(ra, rb);
        m2a = m1a; m2b = m1b; m1a = ma; m1b = mb;
    }
}

struct Args { const float* in[17]; float* out; unsigned char* ws; int ph_lo, ph_hi; };
__global__ void __launch_bounds__(NWAVES * 64, 2) fwd_megakernel(Args args) {
    extern __shared__ __attribute__((aligned(16))) unsigned char lds_raw[];
    LAS unsigned char* lds = (LAS unsigned char*)lds_raw;
    cg::grid_group grid = cg::this_grid();
    const int tid = threadIdx.x, lane = tid & 63, wave = __builtin_amdgcn_readfirstlane(tid >> 6);
    const int G = gridDim.x, bx = blockIdx.x;
    const int gw = bx * NWAVES + wave, NGW = G * NWAVES;
    unsigned char* ws = args.ws;
#define xin ((const float*)args.in[0])
#define pin ((const float*)args.in[1])
#define g_pre_mix ((const float*)args.in[2])
#define w_in ((const float*)args.in[3])
#define b_gate ((const float*)args.in[4])
#define w_conv ((const float*)args.in[5])
#define w_attn_out ((const float*)args.in[6])
#define w_conv_out ((const float*)args.in[7])
#define w_o ((const float*)args.in[8])
#define g_post_mix ((const float*)args.in[9])
#define g_pre_mlp ((const float*)args.in[10])
#define w_up ((const float*)args.in[11])
#define w_down ((const float*)args.in[12])
#define g_post_mlp ((const float*)args.in[13])
#define g_ple ((const float*)args.in[14])
#define w_ple_gate ((const float*)args.in[15])
#define w_ple_proj ((const float*)args.in[16])
    float* out = args.out;
    bf16* Win_t = (bf16*)(ws + WS_WIN); bf16* Wa_t = (bf16*)(ws + WS_WA); bf16* Wc_t = (bf16*)(ws + WS_WC); bf16* Wo_t = (bf16*)(ws + WS_WO);
    bf16* Wup_t = (bf16*)(ws + WS_WUP); bf16* Wdn_t = (bf16*)(ws + WS_WDN); bf16* Wpg_t = (bf16*)(ws + WS_WPG); bf16* Wpp_t = (bf16*)(ws + WS_WPP);
    bf16* R1 = (bf16*)(ws + WS_R1); bf16* R2 = (bf16*)(ws + WS_R2); bf16* R3 = (bf16*)(ws + WS_R3); bf16* PB = (bf16*)(ws + WS_PB);
    bf16* XN = R1; bf16* MB = R1; bf16* PPB = R1;
    bf16* OB = R2; bf16* CM = R2 + AW; bf16* XB = R2;
    float* SS2 = (float*)(ws + WS_SS2); float* SS3 = (float*)(ws + WS_SS3);
    bf16* PROJ = R3; bf16* HB = R3;
    const int lo = args.ph_lo, hi = args.ph_hi;
    volatile LAS unsigned* bst = (volatile LAS unsigned*)(lds + RING_BYTES + 384);
    if (tid < 2) bst[tid] = 0u;
    __syncthreads();
    if (lo < 0) grid.sync();
    XcdBarrier bar; bar.bar = (unsigned*)ws; bar.x = 0; bar.st = bst;
    if (hi - lo > 1) bar = xcd_barrier_post((unsigned*)ws, bst);
#ifndef PROBE_DUP_MASK
#define PROBE_DUP_MASK 0
#endif
#ifndef PROBE_P9_MODE
#define PROBE_P9_MODE 1
#endif
#ifndef PROBE_DUP_SYNC
#define PROBE_DUP_SYNC 0
#endif
#define IN(k) (lo <= (k) && (k) < hi)
#define REP(k) for (int rep_ = 0; rep_ < (((PROBE_DUP_MASK >> (k)) & 1) ? 2 : 1); ++rep_)
#ifndef STAG_US
#define STAG_US 0
#endif
#define STAGGER() do { const unsigned sg_ = ((unsigned)bx >> 3) & 3u; if (STAG_US && sg_) { const unsigned long long t0_ = __builtin_amdgcn_s_memrealtime(); while (__builtin_amdgcn_s_memrealtime() - t0_ < (unsigned long long)(sg_ * STAG_US * 10u)) __builtin_amdgcn_s_sleep(8); } } while (0)
#define STAGGER2(tenths) do { if ((tenths) && (((unsigned)bx >> 3) & 1u)) { const unsigned long long t0_ = __builtin_amdgcn_s_memrealtime(); while (__builtin_amdgcn_s_memrealtime() - t0_ < (unsigned long long)((tenths) * 10u)) __builtin_amdgcn_s_sleep(8); } } while (0)
#ifndef STAG_P3
#define STAG_P3 0
#endif
#ifndef STAG_P4
#define STAG_P4 0
#endif
#ifndef STAG_P7
#define STAG_P7 0
#endif
#ifndef STAG_P9
#define STAG_P9 0
#endif
#define SEAM(k) do { if (IN(k) && IN((k) + 1)) { xcd_barrier(bar); if (PROBE_DUP_SYNC) xcd_barrier(bar); } } while (0)

    constexpr int I_IN = (D / 64) * (DIN / 32), I_A = (AW / 64) * (D / 32), I_O = (D / 64) * (D / 32), I_UP = (D / 64) * (FF / 32), I_DN = (FF / 64) * (D / 32), I_PP = (PLE / 64) * (D / 32);
    if (IN(0)) REP(0) {
        LAS float* scr = (LAS float*)(lds + wave * 16384);
        for (int it = gw; it < I_IN; it += NGW) p0_transpose_item(w_in, D, DIN, Win_t, scr, it, lane, nullptr, 0, true);
        for (int m = gw; m < M; m += NGW) rms_row_to_bf16(xin + (size_t)m * D, g_pre_mix, XN + (size_t)m * D, lane);
        __syncthreads();
    }
    SEAM(0);
    if (IN(1)) REP(1) {
        STAGGER();
        pg8::Gemm g{XN, Win_t, M, DIN, D}; pg8::StaticOrder S; S.init(M, DIN, G, bx);
        pg8::EpiTile8<pg8::FProj> E{{PROJ, b_gate}};
        pg8::gemm_phase<pg8::EpiTile8<pg8::FProj>, pg8::StaticOrder, true, true>(lds, g, S, E);
    }
    SEAM(1);
    if (IN(2)) REP(2) {
        constexpr int NQT = SEQ / 32, NUNITS = BATCH * NH * NQT;
        for (int pass = 0; pass < 2; ++pass) {
            if ((pass ^ (wave >> 2)) & 1) {
                LAS float* scr = (LAS float*)(lds + wave * 16384);
                constexpr int NITEMS = 2 * I_A + 2 * I_O + I_UP + I_DN + I_PP;
                for (int it = gw; it < NITEMS; it += NGW) {
                    int r = it; const float* W; int K_, N_; bf16* WT; const float* gain = nullptr; int ldw = 0;
                    if (r < I_A) { W = w_attn_out; K_ = AW; N_ = D; WT = Wa_t; ldw = D; }
                    else if ((r -= I_A) < I_A) { W = w_conv_out; K_ = AW; N_ = D; WT = Wa_t + AW; ldw = D; }
                    else if ((r -= I_A) < I_O) { W = w_o; K_ = D; N_ = D; WT = Wo_t; }
                    else if ((r -= I_O) < I_UP) { W = w_up; K_ = D; N_ = FF; WT = Wup_t; gain = g_pre_mlp; }
                    else if ((r -= I_UP) < I_DN) { W = w_down; K_ = FF; N_ = D; WT = Wdn_t; }
                    else if ((r -= I_DN) < I_O) { W = w_ple_gate; K_ = D; N_ = D; WT = Wpg_t; gain = g_ple; ldw = D + PLE; }
                    else { r -= I_O; W = w_ple_proj; K_ = PLE; N_ = D; WT = Wpg_t + D; ldw = D + PLE; }
                    p0_transpose_item(W, K_, N_, WT, scr, r, lane, gain, ldw);
                }
                for (int it = gw * 64 + lane; it < (M / 16) * 64; it += NGW * 64) conv_item(PROJ, w_conv, CM, it);
                for (int i = gw * 64 + lane; i < M * PLE / 8; i += NGW * 64) {
                    const f32x4 a = *(const f32x4*)(pin + (size_t)i * 8), b2 = *(const f32x4*)(pin + (size_t)i * 8 + 4);
                    *(v4u*)(PB + (size_t)i * 8) = pg8::pack8(a, b2);
                }
            } else {
                for (int u = gw; u < NUNITS; u += NGW) { const int qt = u % NQT, bh = u / NQT; attn_unit(PROJ, OB, bh / NH, bh % NH, qt, lane); }
            }
        }
        __syncthreads();
    }
    SEAM(2);
    if (IN(3)) REP(3) {
        pg8::Gemm g{OB, Wa_t, M, D, D}; pg8::StaticOrder S; S.init(M, D, G, bx);
        pg8::EpiTile8<pg8::FMix> E{{MB, PROJ + C_GA, PROJ + C_GC}};
        pg8::gemm_phase<pg8::EpiTile8<pg8::FMix>, pg8::StaticOrder, true, true>(lds, g, S, E);
    }
    SEAM(3);
    if (IN(4)) REP(4) {
        STAGGER2(STAG_P4);
        pg8::Gemm g{MB, Wo_t, M, D, D}; pg8::StaticOrder S; S.init(M, D, G, bx);
        pg8::PanelRms s1{(unsigned*)(ws + WS_XB), (unsigned*)(ws + WS_CNT), EPS};
        pg8::EpiRmsRes<false> E{xin, XB, g_post_mix, SS2, s1, lds + RING_BYTES + 1024};
        pg8::gemm_phase<pg8::EpiRmsRes<false>, pg8::StaticOrder, true, true>(lds, g, S, E);
    }
    SEAM(4);
    if (IN(6)) REP(6) {
        pg8::Gemm g{XB, Wup_t, M, FF, D}; pg8::StaticOrder S; S.init(M, FF, G, bx);
        pg8::EpiTile8<pg8::FStoreRt> E{{HB, FF, 1, SS2, EPS, lds + RING_BYTES + 1024 + 4096, -1}};
        pg8::gemm_phase<pg8::EpiTile8<pg8::FStoreRt>, pg8::StaticOrder, true, true>(lds, g, S, E);
    }
    SEAM(6);
    if (IN(7)) REP(7) {
        STAGGER2(STAG_P7);
        pg8::Gemm g{HB, Wdn_t, M, D, FF}; pg8::StaticOrder S; S.init(M, D, G, bx);
        pg8::PanelRms s1{(unsigned*)(ws + WS_XB + 512 * 1024), (unsigned*)(ws + WS_CNT + 32768), EPS};
        pg8::EpiRmsRes<true> E{XB, XB, g_post_mlp, SS3, s1, lds + RING_BYTES + 1024};
        pg8::gemm_phase<pg8::EpiRmsRes<true>, pg8::StaticOrder, true, true>(lds, g, S, E);
    }
    SEAM(7);
    if (IN(9)) REP(9) {
        pg8::Gemm2 g{XB, PB, Wpg_t, M, D, D + PLE, D, PLE, D / 64}; pg8::StaticOrder S; S.init(M, D, G, bx);
        LAS float* rtab = (LAS float*)(lds + RING_BYTES + 1024 + 4096);
        pg8::Unit u0{0, 0}, u1{0, 0}, u2{0, 0}; const bool h0 = S.next(0, u0), h1 = S.next(1, u1), h2 = S.next(2, u2);
        const int use_tab = (h0 && !h2) ? 1 : 0;
        if (use_tab) { const int t = threadIdx.x & 255, w = threadIdx.x >> 8;
            if (w == 0 || h1) rtab[w * 256 + t] = pg8::rstd16(SS3, (w ? u1.pm : u0.pm) * 256 + t, EPS); }
        __syncthreads();
        pg8::EpiTile8<pg8::FFinal> E{{XB, out, PPB, SS3, EPS, rtab, u0.pm, use_tab}};
        pg8::gemm_phase_split<pg8::EpiTile8<pg8::FFinal>, pg8::StaticOrder, true, true>(lds, g, S, E);
    }
#undef IN
#undef SEAM
#undef xin
#undef pin
#undef g_pre_mix
#undef w_in
#undef b_gate
#undef w_conv
#undef w_attn_out
#undef w_conv_out
#undef w_o
#undef g_post_mix
#undef g_pre_mlp
#undef w_up
#undef w_down
#undef g_post_mlp
#undef g_ple
#undef w_ple_gate
#undef w_ple_proj
}

#ifndef MK_N_LAUNCHES
#define MK_N_LAUNCHES 1
#endif
constexpr int N_PHASES = 10;
extern "C" void kernel_launch(void* const* d_in, const int* in_sizes, int n_in, void* d_out, int out_size, void* d_ws, size_t ws_size, hipStream_t stream) {
    static int grid = 0;
    if (grid == 0) {
        if (n_in != 17 || in_sizes[0] != M * D || out_size != M * D || ws_size < WS_END) { fprintf(stderr, "kernel_launch: unexpected shapes (n_in %d, in0 %d, out %d, ws %zu)\n", n_in, n_in > 0 ? in_sizes[0] : -1, out_size, ws_size); grid = -1; return; }
        int dev = 0, cus = 0, per_cu = 0;
        hipGetDevice(&dev); hipDeviceGetAttribute(&cus, hipDeviceAttributeMultiprocessorCount, dev);
        if (hipFuncSetAttribute((const void*)fwd_megakernel, hipFuncAttributeMaxDynamicSharedMemorySize, LDS_BYTES) != hipSuccess) { fprintf(stderr, "kernel_launch: hipFuncSetAttribute failed\n"); grid = -1; return; }
        if (hipOccupancyMaxActiveBlocksPerMultiprocessor(&per_cu, (const void*)fwd_megakernel, NWAVES * 64, LDS_BYTES) != hipSuccess || per_cu < 1) { fprintf(stderr, "kernel_launch: occupancy query says %d\n", per_cu); per_cu = 1; }
        (void)hipGetLastError();
        grid = cus * per_cu;
        fprintf(stderr, "kernel_launch: grid %d (cus %d x %d)\n", grid, cus, per_cu);
    }
    if (grid < 0) return;
    Args a{};
    for (int i = 0; i < 17; ++i) a.in[i] = (const float*)d_in[i];
    a.out = (float*)d_out; a.ws = (unsigned char*)d_ws;
#if MK_N_LAUNCHES == 1
    a.ph_lo = 0; a.ph_hi = N_PHASES;
    if (hipMemsetAsync(d_ws, 0, 262144, stream) != hipSuccess) { fprintf(stderr, "kernel_launch: memset failed\n"); return; }
    void* kargs[] = {&a};
    hipError_t e = hipLaunchCooperativeKernel((const void*)fwd_megakernel, dim3(grid), dim3(NWAVES * 64), kargs, LDS_BYTES, stream);
    if (e != hipSuccess) fprintf(stderr, "cooperative launch failed: %s (grid %d)\n", hipGetErrorString(e), grid);
#else
    for (int ph = 0; ph < N_PHASES; ++ph) { a.ph_lo = ph; a.ph_hi = ph + 1; hipLaunchKernelGGL(fwd_megakernel, dim3(grid), dim3(NWAVES * 64), LDS_BYTES, stream, a); }
#endif
}
```
